# Optimizing an MI355X kernel written in HIP

```python
import functools
import jax, jax.numpy as jnp
from jax import lax
import numpy as np

D_MODEL = 2048
BATCH = 8
SEQ = 4096
DEPTH = 1
DEC_BATCH = 16
DEC_SEQ = 16
PAST_LEN = 4096

CHUNK = 64
N_RET_HEADS = 8
RET_DK = 128
RET_DV = 256
RET_QK = N_RET_HEADS * RET_DK
RET_V = N_RET_HEADS * RET_DV
N_ATT_HEADS = 8
ATT_HEAD_DIM = 128
ATT_W = N_ATT_HEADS * ATT_HEAD_DIM
ATT_LEFT_CHUNKS = 8
ATT_REACH = ATT_LEFT_CHUNKS * CHUNK
BAND = ATT_REACH + CHUNK
REL_CLIP = 128
D_FF = 5632
CONV_W = 3
ROPE_BASE = 10000.0
EPS = 1e-6
IN_SIZES = (RET_QK, RET_QK, RET_V, RET_V, ATT_W, ATT_W, ATT_W, D_MODEL, D_MODEL)
IN_WIDTH = 2 * RET_QK + 2 * RET_V + 3 * ATT_W + 2 * D_MODEL

kernel_name = 'hybrid_retention_chunkband_convffn_step'


def rms_norm(x, g=None):
    xf = x.astype(jnp.float32)
    y = (xf * lax.rsqrt(jnp.mean(xf * xf, axis=-1, keepdims=True) + EPS)).astype(x.dtype)
    return y if g is None else y * g


def rotary(x, pos):
    half = x.shape[-1] // 2
    inv = ROPE_BASE ** (-jnp.arange(half, dtype=jnp.float32) / half)
    ang = pos.astype(jnp.float32)[:, None] * inv[None, :]
    cos = jnp.cos(ang)[:, None, :].astype(x.dtype)
    sin = jnp.sin(ang)[:, None, :].astype(x.dtype)
    x1, x2 = x[..., :half], x[..., half:]
    return jnp.concatenate([x1 * cos - x2 * sin, x1 * sin + x2 * cos], axis=-1)


def retention_block(state, q, k, v, log_gamma):
    L = q.shape[1]
    dt = q.dtype
    t = jnp.arange(L, dtype=jnp.float32)
    decay_in = jnp.exp(log_gamma[:, None, None] * jnp.abs(t[:, None] - t[None, :])).astype(dt)
    decay_q = jnp.exp((t[:, None] + 1.0) * log_gamma[None, :]).astype(dt)
    decay_k = jnp.exp((L - 1.0 - t)[:, None] * log_gamma[None, :]).astype(dt)
    decay_s = jnp.exp(L * log_gamma).astype(dt)
    s = jnp.einsum('bnhd,bmhd->bhnm', q, k) * decay_in[None]
    o = (jnp.einsum('bhnm,bmhe->bnhe', s, v)
         + jnp.einsum('bnhd,bhde->bnhe', q, state) * decay_q[None, :, :, None])
    new_state = (decay_s[None, :, None, None] * state
                 + jnp.einsum('bmhd,bmhe->bhde', k * decay_k[None, :, :, None], v))
    return new_state, o


def retention_prompt(q, k, v, log_gamma):
    B, S, H, dk = q.shape
    nc = S // CHUNK

    def to_chunks(t):
        return t.reshape(B, nc, CHUNK, H, t.shape[-1]).swapaxes(0, 1)

    s0 = jnp.zeros((B, H, dk, v.shape[-1]), q.dtype)
    s_fin, o = lax.scan(lambda st, xs: retention_block(st, xs[0], xs[1], xs[2], log_gamma),
                        s0, (to_chunks(q), to_chunks(k), to_chunks(v)))
    return o.swapaxes(0, 1).reshape(B, S, H, v.shape[-1]), s_fin


def retention_sample(q, k, v, state, log_gamma):
    new_state, o = retention_block(state, q, k, v, log_gamma)
    return o, new_state


def band_attention(q, k, v, q_pos, k_pos, k_valid, rel_bias):
    s = jnp.einsum('bqhd,bkhd->bhqk', q, k).astype(jnp.float32) * (q.shape[-1] ** -0.5)
    rel = jnp.clip(k_pos[None, :] - q_pos[:, None], -REL_CLIP, REL_CLIP) + REL_CLIP
    s = s + rel_bias[:, rel].astype(jnp.float32)[None]
    s = jnp.where(k_valid[None, None, None, :], s, -1e30)
    p = jax.nn.softmax(s, axis=-1).astype(v.dtype)
    return jnp.einsum('bhqk,bkhd->bqhd', p, v)


def attention_prompt(q, k, v, rel_bias):
    B, S, H, dh = q.shape
    nc = S // CHUNK
    pad = jnp.zeros((B, ATT_REACH, H, dh), k.dtype)
    kp = jnp.concatenate([pad, k], axis=1)
    vp = jnp.concatenate([pad, v], axis=1)

    def one_chunk(c):
        start = c * CHUNK
        qc = lax.dynamic_slice_in_dim(q, start, CHUNK, axis=1)
        kb = lax.dynamic_slice_in_dim(kp, start, BAND, axis=1)
        vb = lax.dynamic_slice_in_dim(vp, start, BAND, axis=1)
        q_pos = start + jnp.arange(CHUNK)
        k_pos = start - ATT_REACH + jnp.arange(BAND)
        return band_attention(qc, kb, vb, q_pos, k_pos, k_pos >= 0, rel_bias)

    o = lax.map(one_chunk, jnp.arange(nc))
    keep = min(ATT_REACH, S)
    return o.swapaxes(0, 1).reshape(B, S, H, dh), k[:, S - keep:], v[:, S - keep:]


def attention_sample(q, k, v, cache_k, cache_v, rel_bias):
    L = q.shape[1]
    P = cache_k.shape[1]
    kb = jnp.concatenate([cache_k, k], axis=1)
    vb = jnp.concatenate([cache_v, v], axis=1)
    q_pos = PAST_LEN + jnp.arange(L)
    k_pos = jnp.concatenate([PAST_LEN - P + jnp.arange(P), q_pos])
    o = band_attention(q, kb, vb, q_pos, k_pos, k_pos >= PAST_LEN - ATT_REACH, rel_bias)
    return o, k, v


def conv_ffn(u, conv_buf, w_up, conv_w, conv_b, w_down):
    L = u.shape[1]
    up = u @ w_up
    ext = jnp.concatenate([conv_buf.astype(up.dtype), up], axis=1)
    h = conv_b + conv_w[CONV_W - 1] * ext[:, CONV_W - 1:]
    for j in range(CONV_W - 1):
        h = h + conv_w[j] * ext[:, j:j + L]
    value, gate = jnp.split(h, 2, axis=-1)
    out = (jax.nn.gelu(gate, approximate=True) * value) @ w_down
    return out, ext[:, L:]


def layer_step(x, c, pos, ret_mix, att_mix, conv_buf, w_ada, b_ada, g_pre1, w_in, w_br_ret,
               w_br_att, w_out, g_post1, g_pre2, w_up, conv_w, conv_b, w_down, g_post2):
    B, L, _ = x.shape
    mod = (jax.nn.silu(c) @ w_ada + b_ada)[:, None, :]
    sh1, sc1, gt1, sh2, sc2, gt2 = jnp.split(mod, 6, axis=-1)

    u = rms_norm(x, g_pre1) * (1.0 + sc1) + sh1
    proj = u @ w_in
    idx = np.cumsum(np.array(IN_SIZES))[:-1].tolist()
    rq, rk, rv, rg, aq, ak, av, gr, ga = jnp.split(proj, idx, axis=-1)

    rq = rotary(rq.reshape(B, L, N_RET_HEADS, RET_DK), pos)
    rk = rotary(rk.reshape(B, L, N_RET_HEADS, RET_DK), pos) * (RET_DK ** -0.5)
    rv = rv.reshape(B, L, N_RET_HEADS, RET_DV)
    o_ret, ret_state = ret_mix(rq, rk, rv)
    y_ret = (jax.nn.silu(rg) * rms_norm(o_ret).reshape(B, L, RET_V)) @ w_br_ret

    aq = aq.reshape(B, L, N_ATT_HEADS, ATT_HEAD_DIM)
    ak = ak.reshape(B, L, N_ATT_HEADS, ATT_HEAD_DIM)
    av = av.reshape(B, L, N_ATT_HEADS, ATT_HEAD_DIM)
    o_att, k_rows, v_rows = att_mix(aq, ak, av)
    y_att = o_att.reshape(B, L, ATT_W) @ w_br_att

    merged = jax.nn.sigmoid(gr) * y_ret + jax.nn.sigmoid(ga) * y_att
    x = x + gt1 * rms_norm(merged @ w_out, g_post1)

    u2 = rms_norm(x, g_pre2) * (1.0 + sc2) + sh2
    f, conv_state = conv_ffn(u2, conv_buf, w_up, conv_w, conv_b, w_down)
    x = x + gt2 * rms_norm(f, g_post2)
    return x, ret_state, k_rows, v_rows, conv_state


def setup_inputs(seed: int = 0) -> dict:
    key = jax.random.key(seed)
    ks = jax.random.split(key, 24)

    def nrm(k, shape, scale):
        return jax.random.normal(k, shape, jnp.float32) * scale

    P = min(ATT_REACH, PAST_LEN)
    L = DEPTH
    return {
        'x_prompt': nrm(ks[0], (BATCH, SEQ, D_MODEL), 1.0),
        'x_sample': nrm(ks[1], (DEC_BATCH, DEC_SEQ, D_MODEL), 1.0),
        'cache_att_k': nrm(ks[2], (L, DEC_BATCH, P, N_ATT_HEADS, ATT_HEAD_DIM), 1.0),
        'cache_att_v': nrm(ks[3], (L, DEC_BATCH, P, N_ATT_HEADS, ATT_HEAD_DIM), 1.0),
        'state_ret': nrm(ks[4], (L, DEC_BATCH, N_RET_HEADS, RET_DK, RET_DV), 1.0),
        'state_conv': nrm(ks[5], (L, DEC_BATCH, CONV_W - 1, 2 * D_FF), 1.0),
        'c_prompt': nrm(ks[6], (BATCH, D_MODEL), 1.0),
        'c_sample': nrm(ks[7], (DEC_BATCH, D_MODEL), 1.0),
        'w_ada': nrm(ks[8], (L, D_MODEL, 6 * D_MODEL), D_MODEL ** -0.5),
        'b_ada': nrm(ks[9], (L, 6 * D_MODEL), 0.01),
        'g_pre1': 1.0 + nrm(ks[10], (L, D_MODEL), 0.01),
        'w_in': nrm(ks[11], (L, D_MODEL, IN_WIDTH), D_MODEL ** -0.5),
        'rel_bias': nrm(ks[12], (L, N_ATT_HEADS, 2 * REL_CLIP + 1), 0.5),
        'w_br_ret': nrm(ks[13], (L, RET_V, D_MODEL), RET_V ** -0.5),
        'w_br_att': nrm(ks[14], (L, ATT_W, D_MODEL), ATT_W ** -0.5),
        'w_out': nrm(ks[15], (L, D_MODEL, D_MODEL), D_MODEL ** -0.5),
        'g_post1': 1.0 + nrm(ks[16], (L, D_MODEL), 0.01),
        'g_pre2': 1.0 + nrm(ks[17], (L, D_MODEL), 0.01),
        'w_up': nrm(ks[18], (L, D_MODEL, 2 * D_FF), D_MODEL ** -0.5),
        'conv_w': nrm(ks[19], (L, CONV_W, 2 * D_FF), CONV_W ** -0.5),
        'conv_b': nrm(ks[20], (L, 2 * D_FF), 0.01),
        'w_down': nrm(ks[21], (L, D_FF, D_MODEL), D_FF ** -0.5),
        'g_post2': 1.0 + nrm(ks[22], (L, D_MODEL), 0.01),
    }


def reference(x_prompt, x_sample, cache_att_k, cache_att_v, state_ret, state_conv, c_prompt, c_sample,
              w_ada, b_ada, g_pre1, w_in, rel_bias, w_br_ret, w_br_att, w_out, g_post1, g_pre2,
              w_up, conv_w, conv_b, w_down, g_post2):
    log_gamma = jnp.log(1.0 - 2.0 ** (-5.0 - jnp.arange(N_RET_HEADS, dtype=jnp.float32)))
    pos_p = jnp.arange(x_prompt.shape[1])
    pos_s = PAST_LEN + jnp.arange(x_sample.shape[1])
    conv0 = jnp.zeros((x_prompt.shape[0], CONV_W - 1, 2 * D_FF), x_prompt.dtype)
    yp, ys = x_prompt, x_sample
    kp_l, vp_l, rp_l, cp_l, ks_l, vs_l, rs_l, cs_l = [], [], [], [], [], [], [], []
    for l in range(DEPTH):
        lw = (w_ada[l], b_ada[l], g_pre1[l], w_in[l], w_br_ret[l], w_br_att[l], w_out[l], g_post1[l],
              g_pre2[l], w_up[l], conv_w[l], conv_b[l], w_down[l], g_post2[l])
        ret_p = functools.partial(retention_prompt, log_gamma=log_gamma)
        att_p = functools.partial(attention_prompt, rel_bias=rel_bias[l])
        ret_s = functools.partial(retention_sample, state=state_ret[l], log_gamma=log_gamma)
        att_s = functools.partial(attention_sample, cache_k=cache_att_k[l], cache_v=cache_att_v[l],
                                  rel_bias=rel_bias[l])
        yp, r_p, k_p, v_p, cv_p = layer_step(yp, c_prompt, pos_p, ret_p, att_p, conv0, *lw)
        ys, r_s, k_s, v_s, cv_s = layer_step(ys, c_sample, pos_s, ret_s, att_s, state_conv[l], *lw)
        kp_l.append(k_p); vp_l.append(v_p); rp_l.append(r_p); cp_l.append(cv_p)
        ks_l.append(k_s); vs_l.append(v_s); rs_l.append(r_s); cs_l.append(cv_s)
    return (yp, ys, jnp.stack(kp_l), jnp.stack(vp_l), jnp.stack(rp_l), jnp.stack(cp_l),
            jnp.stack(ks_l), jnp.stack(vs_l), jnp.stack(rs_l), jnp.stack(cs_l))
```

```cpp
#include <hip/hip_runtime.h>
#include <hip/hip_cooperative_groups.h>
#include <cstdio>
#include <cstdint>
namespace cg = cooperative_groups;
#define DI __device__ __forceinline__
namespace pg8 {
#define PG8_LAS __attribute__((address_space(3)))
typedef unsigned short bf16_t;
typedef short bf16x8 __attribute__((ext_vector_type(8)));
typedef float f32x4 __attribute__((ext_vector_type(4)));
typedef unsigned u32x4 __attribute__((ext_vector_type(4)));
typedef unsigned u32x2 __attribute__((ext_vector_type(2)));
constexpr int BM = 256, BK = 64, HALF = 128, HTB = HALF * BK * 2, STAGE_BYTES = 8 * HTB, NXCD = 8, WGM = 8;
__host__ __device__ __forceinline__ int lds_byte(int r, int c) { const int st = (r >> 4) * 2 + (c >> 5), rr = r & 15, cc = c & 31, ob = rr * 64 + cc * 2; return st * 1024 + (ob ^ (((ob >> 9) & 1) << 5)); }
__host__ __device__ __forceinline__ void stage_rc(int b, int& R, int& C) { const int st = b / 1024, sb = b % 1024, swz = sb ^ (((sb >> 9) & 1) << 5); R = (st >> 1) * 16 + swz / 64; C = (st & 1) * 32 + (swz % 64) / 2; }
__host__ __device__ __forceinline__ int perm32(int rho) { const int n = rho >> 4, i = rho & 15; return 8 * (i >> 2) + 4 * n + (i & 3); }
struct Unit { int pm, pn; };
struct Gemm { const bf16_t* A; int lda; const bf16_t* Bt; int K; int spm; const bf16_t* As; int ldb = 0; size_t a_tile_bytes = 0, b_pm_bytes = 0; };
__device__ __forceinline__ const char* tileA(const Gemm& g, int pm, size_t tstepA) { return pm == g.spm ? (const char*)g.As : (const char*)g.A + (size_t)pm * (g.a_tile_bytes ? g.a_tile_bytes : tstepA); }
struct StaticOrder {
    int nM, nN, nwg, G, c;
    __host__ __device__ void init(int nM_, int nN_, int G_, int c_) { nM = nM_; nN = nN_; nwg = nM * nN; G = G_; c = c_; }
    __host__ __device__ bool next(int i, Unit& u) const {
        const long L = (long)i * G + c; if (L >= nwg) return false;
        int wgid = (int)L; { const int q = nwg / NXCD, r = nwg % NXCD, xcd = wgid % NXCD, off = wgid / NXCD; wgid = (xcd < r ? xcd * (q + 1) : r * (q + 1) + (xcd - r) * q) + off; }
        const int nig = WGM * nN, gid = wgid / nig, fm = gid * WGM, gsz = (nM - fm) < WGM ? (nM - fm) : WGM;
        u.pm = fm + ((wgid % nig) % gsz); u.pn = (wgid % nig) / gsz; return true;
    }
    __device__ __forceinline__ void a_ready(const Unit&) const {}
    __device__ __forceinline__ void done(const Unit&) const {}
};
__device__ __forceinline__ unsigned cvt_pk_bf16(float lo, float hi) { unsigned r; asm volatile("v_cvt_pk_bf16_f32 %0, %1, %2" : "=v"(r) : "v"(lo), "v"(hi)); return r; }
template <class Epi, class Sched, bool ALIGN_EPI = false, bool SP2 = false>
__device__ __forceinline__ void gemm_phase(PG8_LAS unsigned char* lds, const Gemm g, const Sched& S, const Epi& E) {
    int tid_ = threadIdx.x; asm volatile("" : "+v"(tid_));
    const int tid = tid_, wid = __builtin_amdgcn_readfirstlane(tid >> 6), lane = tid & 63, wr = wid >> 2, wc = wid & 3, fr = lane & 15, fq = lane >> 4;
    const int K = g.K, nt = K / BK;
    unsigned voffA[2], voffB[2];
#pragma unroll
    for (int i = 0; i < 2; ++i) { int R, C; stage_rc(tid * 16 + i * 8192, R, C); const int Rb = Epi::PERM ? ((R & ~31) + perm32(R & 31)) : R;
        voffA[i] = (unsigned)(R * g.lda + C) * 2u; voffB[i] = (unsigned)(Rb * (g.ldb ? g.ldb : K) + C) * 2u; }
    const size_t kstep = (size_t)(BK * 2);
    const size_t hstepA = (size_t)HALF * g.lda * 2, hstepB = (size_t)HALF * (g.ldb ? g.ldb : K) * 2;
    const size_t tstepA = 2 * hstepA, tstepB = 2 * hstepB;
    const unsigned ldsw = (unsigned)wid * 1024u;
    const int aoff = lds_byte(wr * 64 + fr, fq * 8), boff = lds_byte(wc * 32 + fr, fq * 8);
#define PG8_SA(b, h) (((b) * 2 + (h)) * HTB)
#define PG8_SB(b, h) ((4 + (b) * 2 + (h)) * HTB)
#define PG8_STAGE(bufoff, gbase, voff) do { _Pragma("unroll") for (int _i = 0; _i < 2; ++_i) \
        __builtin_amdgcn_global_load_lds((const unsigned*)((const char*)(gbase) + (voff)[_i]), (PG8_LAS unsigned*)(lds + (bufoff) + ldsw + _i * 8192), 16, 0, 0); } while (0)
#define PG8_LDA(dst, b, h) do { _Pragma("unroll") for (int m = 0; m < 4; ++m) _Pragma("unroll") for (int k = 0; k < 2; ++k) dst[m][k] = *(const PG8_LAS bf16x8*)(lds + PG8_SA(b, h) + aoff + m * 2048 + k * 1024); } while (0)
#define PG8_LDB(dst, b, h) do { _Pragma("unroll") for (int n = 0; n < 2; ++n) _Pragma("unroll") for (int k = 0; k < 2; ++k) dst[n][k] = *(const PG8_LAS bf16x8*)(lds + PG8_SB(b, h) + boff + n * 2048 + k * 1024); } while (0)
#define PG8_MMA(ai, bj, At, Bt) do { __builtin_amdgcn_s_setprio(1); _Pragma("unroll") for (int m = 0; m < 4; ++m) _Pragma("unroll") for (int n = 0; n < 2; ++n) _Pragma("unroll") for (int k = 0; k < 2; ++k) \
        acc[ai][bj][m][n] = __builtin_amdgcn_mfma_f32_16x16x32_bf16(Bt[n][k], At[m][k], acc[ai][bj][m][n], 0, 0, 0); __builtin_amdgcn_s_setprio(0); } while (0)
#define PG8_WAIT_V(n) asm volatile("s_waitcnt vmcnt(" #n ")" ::: "memory")
#define PG8_WAIT_L(n) asm volatile("s_waitcnt lgkmcnt(" #n ")" ::: "memory")
#define PG8_BAR __builtin_amdgcn_s_barrier()
#define PG8_SCHED __builtin_amdgcn_sched_barrier(0)
    Unit cur, nxt; int ui = 0;
    if (!S.next(0, cur)) return;
    f32x4 acc[2][2][4][2];
#pragma unroll
    for (int a = 0; a < 2; ++a)
#pragma unroll
        for (int b = 0; b < 2; ++b)
#pragma unroll
            for (int m = 0; m < 4; ++m)
#pragma unroll
                for (int n = 0; n < 2; ++n) acc[a][b][m][n] = (f32x4){0.f, 0.f, 0.f, 0.f};
    bf16x8 At[4][2], B0[2][2], B1[2][2];
    const char* cA = tileA(g, cur.pm, tstepA); const char* cB = (const char*)g.Bt + (size_t)cur.pn * tstepB + (size_t)cur.pm * g.b_pm_bytes;
    S.a_ready(cur);
    if constexpr (SP2) {
        PG8_STAGE(PG8_SB(0, 0), cB, voffB); PG8_STAGE(PG8_SB(0, 1), cB + hstepB, voffB); PG8_STAGE(PG8_SA(0, 0), cA, voffA); PG8_STAGE(PG8_SA(0, 1), cA + hstepA, voffA);
        if (wr == 1) PG8_BAR;
        PG8_WAIT_V(2); PG8_BAR;
        PG8_STAGE(PG8_SB(1, 0), cB + kstep, voffB); PG8_STAGE(PG8_SA(1, 0), cA + kstep, voffA); PG8_STAGE(PG8_SB(1, 1), cB + hstepB + kstep, voffB);
        PG8_WAIT_V(6); PG8_BAR;
    } else {
        PG8_STAGE(PG8_SB(0, 0), cB, voffB); PG8_STAGE(PG8_SA(0, 0), cA, voffA); PG8_STAGE(PG8_SB(0, 1), cB + hstepB, voffB); PG8_STAGE(PG8_SA(0, 1), cA + hstepA, voffA);
        if (wr == 1) PG8_BAR;
        PG8_WAIT_V(4); PG8_BAR;
        PG8_STAGE(PG8_SB(1, 0), cB + kstep, voffB); PG8_STAGE(PG8_SA(1, 0), cA + kstep, voffA); PG8_STAGE(PG8_SB(1, 1), cB + hstepB + kstep, voffB);
        PG8_WAIT_V(6); PG8_BAR;
    }
    for (;;) {
        const bool has_next = S.next(ui + 1, nxt);
        const char* nA = has_next ? tileA(g, nxt.pm, tstepA) : cA; const char* nB = has_next ? (const char*)g.Bt + (size_t)nxt.pn * tstepB + (size_t)nxt.pm * g.b_pm_bytes : cB;
        for (int t = 0; t < nt; t += 2) {
            const bool last = (t == nt - 2);
            const char* a1 = cA + (size_t)(t + 1) * kstep;
            const char* a2 = last ? nA : cA + (size_t)(t + 2) * kstep; const char* b2 = last ? nB : cB + (size_t)(t + 2) * kstep;
            const char* a3 = a2 + kstep; const char* b3 = b2 + kstep;
            if (last && has_next) S.a_ready(nxt);
            if constexpr (SP2) {
            PG8_LDB(B0, 0, 0); PG8_LDB(B1, 0, 1); PG8_SCHED; PG8_LDA(At, 0, 0); PG8_STAGE(PG8_SA(1, 1), a1 + hstepA, voffA);
            PG8_WAIT_V(8); PG8_WAIT_L(0); PG8_BAR; PG8_MMA(0, 0, At, B0); PG8_MMA(0, 1, At, B1); PG8_BAR; PG8_SCHED;
            PG8_LDA(At, 0, 1); PG8_STAGE(PG8_SB(0, 0), b2, voffB); PG8_STAGE(PG8_SB(0, 1), b2 + hstepB, voffB); PG8_STAGE(PG8_SA(0, 0), a2, voffA);
            PG8_WAIT_V(8); PG8_WAIT_L(0); PG8_BAR; PG8_MMA(1, 0, At, B0); PG8_MMA(1, 1, At, B1); PG8_BAR; PG8_SCHED;
            PG8_LDB(B0, 1, 0); PG8_LDB(B1, 1, 1); PG8_SCHED; PG8_LDA(At, 1, 0); PG8_STAGE(PG8_SA(0, 1), a2 + hstepA, voffA);
            PG8_WAIT_V(8); PG8_WAIT_L(0); PG8_BAR; PG8_MMA(0, 0, At, B0); PG8_MMA(0, 1, At, B1); PG8_BAR; PG8_SCHED;
            PG8_LDA(At, 1, 1); PG8_STAGE(PG8_SB(1, 0), b3, voffB); PG8_STAGE(PG8_SB(1, 1), b3 + hstepB, voffB); PG8_STAGE(PG8_SA(1, 0), a3, voffA);
            PG8_WAIT_V(8); PG8_WAIT_L(0); PG8_BAR; PG8_MMA(1, 0, At, B0); PG8_MMA(1, 1, At, B1); PG8_BAR; PG8_SCHED;
            } else {
            PG8_LDB(B0, 0, 0); PG8_SCHED; PG8_LDA(At, 0, 0); PG8_STAGE(PG8_SA(1, 1), a1 + hstepA, voffA);
            PG8_WAIT_L(8); PG8_BAR; PG8_WAIT_L(0); PG8_MMA(0, 0, At, B0); PG8_BAR; PG8_SCHED;
            PG8_LDB(B1, 0, 1); PG8_STAGE(PG8_SB(0, 0), b2, voffB);
            PG8_BAR; PG8_WAIT_L(0); PG8_MMA(0, 1, At, B1); PG8_BAR;
            PG8_LDA(At, 0, 1); PG8_STAGE(PG8_SA(0, 0), a2, voffA);
            PG8_BAR; PG8_WAIT_L(0); PG8_MMA(1, 0, At, B0); PG8_BAR; PG8_SCHED;
            PG8_STAGE(PG8_SB(0, 1), b2 + hstepB, voffB);
            PG8_WAIT_V(6); PG8_BAR; PG8_MMA(1, 1, At, B1); PG8_BAR;
            PG8_LDB(B0, 1, 0); PG8_SCHED; PG8_LDA(At, 1, 0); PG8_STAGE(PG8_SA(0, 1), a2 + hstepA, voffA);
            PG8_WAIT_L(8); PG8_BAR; PG8_WAIT_L(0); PG8_MMA(0, 0, At, B0); PG8_BAR; PG8_SCHED;
            PG8_LDB(B1, 1, 1); PG8_STAGE(PG8_SB(1, 0), b3, voffB);
            PG8_BAR; PG8_WAIT_L(0); PG8_MMA(0, 1, At, B1); PG8_BAR;
            PG8_LDA(At, 1, 1); PG8_STAGE(PG8_SA(1, 0), a3, voffA);
            PG8_BAR; PG8_WAIT_L(0); PG8_MMA(1, 0, At, B0); PG8_BAR; PG8_SCHED;
            PG8_STAGE(PG8_SB(1, 1), b3 + hstepB, voffB);
            PG8_WAIT_V(6); PG8_BAR; PG8_MMA(1, 1, At, B1); PG8_BAR;
            }
        }
        if constexpr (ALIGN_EPI) { if (wr == 0) PG8_BAR; }
        if constexpr (!Epi::AFTER_DRAIN) { E(acc, cur, wr, wc, fr, fq); if constexpr (Epi::TWICE) { asm volatile("" ::: "memory"); E(acc, cur, wr, wc, fr, fq); } S.done(cur); }
        if (!has_next) break;
#pragma unroll
        for (int a = 0; a < 2; ++a)
#pragma unroll
            for (int b = 0; b < 2; ++b)
#pragma unroll
                for (int m = 0; m < 4; ++m)
#pragma unroll
                    for (int n = 0; n < 2; ++n) acc[a][b][m][n] = (f32x4){0.f, 0.f, 0.f, 0.f};
        cur = nxt; cA = nA; cB = nB; ++ui;
        if constexpr (ALIGN_EPI) { if (wr == 1) PG8_BAR; }
    }
    PG8_WAIT_V(0);
    if constexpr (!ALIGN_EPI) { if (wr == 0) PG8_BAR; }
    PG8_BAR;
    if constexpr (Epi::AFTER_DRAIN) { E.fused(acc, cur, wr, wc, fr, fq, lds, wid, lane); S.done(cur); }
#undef PG8_SA
#undef PG8_SB
#undef PG8_STAGE
#undef PG8_LDA
#undef PG8_LDB
#undef PG8_MMA
#undef PG8_WAIT_V
#undef PG8_WAIT_L
#undef PG8_BAR
#undef PG8_SCHED
}
}

using pg8::bf16_t; using pg8::bf16x8; using pg8::f32x4; using pg8::u32x4; using pg8::u32x2; using pg8::Unit;
typedef float f32x16 __attribute__((ext_vector_type(16)));
#define LAS __attribute__((address_space(3)))
constexpr int DM = 2048, SEQ = 4096, NBATCH = 8, MP = NBATCH * SEQ, MS = 256, MTOT = MP + MS, NTILE = MTOT / 256;
constexpr int INW = 13312, DFF = 5632, UPW = 2 * DFF;
constexpr int C_RQ = 0, C_RK = 1024, C_RV = 2048, C_RG = 4096, C_AQ = 6144, C_AK = 7168, C_AV = 8192, C_GR = 9216, C_GA = 11264;
constexpr int C_U2 = 0, C_UP = 2048, C_H = 2048, C_F = 2048 + DFF;
constexpr float EPS = 1e-6f;
constexpr size_t OFF_Y = 0, OFF_KP = (size_t)MTOT * DM, OFF_VP = OFF_KP + 4194304, OFF_RP = OFF_VP + 4194304, OFF_CP = OFF_RP + 2097152,
                 OFF_KS = OFF_CP + 180224, OFF_VS = OFF_KS + 262144, OFF_RS = OFF_VS + 262144, OFF_CS = OFF_RS + 4194304;
constexpr size_t MiB = 1u << 20;
constexpr size_t WS_CTL = 0, WS_WIN = 1 * MiB, WS_WUP = 53 * MiB, WS_WDN = 97 * MiB, WS_WBR = 119 * MiB, WS_WBA = 127 * MiB, WS_WOUT = 131 * MiB,
                 WS_MODP = 139 * MiB, WS_MOD = 157 * MiB, WS_SSQ = 159 * MiB, WS_HS = 164 * MiB, WS_PROJ = 171 * MiB, WS_END = WS_PROJ + (size_t)MTOT * INW * 2;
static_assert(WS_END <= 1024 * MiB, "ws map");
constexpr int LDS_BYTES = 147456;
constexpr int MOD_SH1 = 0, MOD_SC1 = 2048, MOD_GT1 = 4096, MOD_SH2 = 6144, MOD_SC2 = 8192, MOD_GT2 = 10240, MODW = 12288;

DI float bf2f(unsigned short v) { return __uint_as_float((unsigned)v << 16); }
typedef __bf16 hwbf2 __attribute__((ext_vector_type(2)));
typedef float hwf2 __attribute__((ext_vector_type(2)));
DI unsigned pk2(float lo, float hi) { hwf2 v = {lo, hi}; return __builtin_bit_cast(unsigned, __builtin_convertvector(v, hwbf2)); }
DI unsigned f2bf(float f) { return pk2(f, f) & 0xffffu; }
DI float wave_sum(float v) {
#pragma unroll
    for (int o = 1; o < 64; o <<= 1) v += __shfl_xor(v, o);
    return v;
}
DI float sigmoidf_(float x) { return __builtin_amdgcn_rcpf(1.f + __expf(-x)); }
DI int crow(int reg, int h) { return (reg & 3) + 8 * (reg >> 2) + 4 * h; }
#define MFMA32(a, b, c) __builtin_amdgcn_mfma_f32_32x32x16_bf16((a), (b), (c), 0, 0, 0)
DI bf16x8 pack_step(const f32x16& x, int s) {
    u32x4 p;
    p[0] = pk2(x[8 * s + 0], x[8 * s + 1]); p[1] = pk2(x[8 * s + 2], x[8 * s + 3]); p[2] = pk2(x[8 * s + 4], x[8 * s + 5]); p[3] = pk2(x[8 * s + 6], x[8 * s + 7]);
    return __builtin_bit_cast(bf16x8, p);
}
DI int mod_row(int r) { return r < MP ? (r >> 12) : 8 + ((r - MP) >> 4); }

#ifndef PHMASK
#define PHMASK 0xffff
#endif
#define PH(k) ((PHMASK >> (k)) & 1)
#ifndef REP_P0
#define REP_P0 1
#endif
#ifndef REP_P1
#define REP_P1 1
#endif
#ifndef REP_FFN
#define REP_FFN 1
#endif
#ifndef P2SUB
#define P2SUB 15
#endif
struct Args { const float* in[23]; float* out; unsigned char* ws; };

#ifndef EPI_TWICE_PROJ
#define EPI_TWICE_PROJ false
#endif
struct EpiProj {
    static constexpr bool PERM = true, AFTER_DRAIN = false, TWICE = EPI_TWICE_PROJ;
    bf16_t* P; float* out;
    DI void operator()(const f32x4 (&acc)[2][2][4][2], const Unit& u, int wr, int wc, int fr, int fq) const {
        const int pn = u.pn, pm = u.pm;
        const int rbase = pm * 256 + wr * 64 + fr;
        if (pn < 8) {
            const float scale = pn >= 4 ? 0.08838834764831845f : 1.f;
            const int i0 = 16 * wc + 4 * fq;
            float inv[4];
#pragma unroll
            for (int e = 0; e < 4; ++e) inv[e] = exp2f(-(float)(i0 + e) * (13.287712379549449f / 64.f));
#pragma unroll
            for (int ai = 0; ai < 2; ++ai)
#pragma unroll
                for (int m = 0; m < 4; ++m) {
                    const int r = rbase + ai * 128 + m * 16;
                    const float pos = (float)(r < MP ? (r & 4095) : 4096 + (r & 15));
                    float cs[4], sn[4];
#pragma unroll
                    for (int e = 0; e < 4; ++e) { float rev = (pos * inv[e]) * 0.15915494309189535f; rev -= floorf(rev); sn[e] = __builtin_amdgcn_sinf(rev); cs[e] = __builtin_amdgcn_cosf(rev); }
                    bf16_t* rowp = P + (size_t)r * INW + pn * 256;
#pragma unroll
                    for (int bj = 0; bj < 2; ++bj) {
                        const f32x4 x1 = acc[ai][bj][m][0], x2 = acc[ai][bj][m][1];
                        float o1[4], o2[4];
#pragma unroll
                        for (int e = 0; e < 4; ++e) { o1[e] = (x1[e] * cs[e] - x2[e] * sn[e]) * scale; o2[e] = (x1[e] * sn[e] + x2[e] * cs[e]) * scale; }
                        u32x2 w1, w2; w1.x = pk2(o1[0], o1[1]); w1.y = pk2(o1[2], o1[3]); w2.x = pk2(o2[0], o2[1]); w2.y = pk2(o2[2], o2[3]);
                        *(u32x2*)(rowp + bj * 128 + i0) = w1; *(u32x2*)(rowp + bj * 128 + 64 + i0) = w2;
                    }
                }
            return;
        }
        const bool isv = (pn >= 8 && pn < 16) || (pn >= 32 && pn < 36);
        if (isv && pm < 128) {
            const int hh = (fr >> 2) & 1, j = ((fr >> 3) << 2) | (fr & 3);
#pragma unroll
            for (int ai = 0; ai < 2; ++ai)
#pragma unroll
                for (int m = 0; m < 4; ++m) {
                    const int rowblk = pm * 256 + ai * 128 + wr * 64 + m * 16;
#pragma unroll
                    for (int bj = 0; bj < 2; ++bj)
#pragma unroll
                        for (int n = 0; n < 2; ++n) {
                            bf16_t* p;
                            if (pn >= 32) { const int bb = (pn - 32) * 8 + bj * 4 + wc;
                                p = P + (size_t)(rowblk + (bb >> 1)) * INW + C_AV + (bb & 1) * 512 + (hh * 32 + 8 * fq + 4 * n) * 8 + j; }
                            else p = P + (size_t)(rowblk + hh * 8 + 2 * fq + n) * INW + pn * 256 + bj * 128 + wc * 32 + j;
                            const f32x4 v = acc[ai][bj][m][n];
#pragma unroll
                            for (int e = 0; e < 4; ++e) p[8 * e] = (bf16_t)f2bf(v[e]);
                        }
                }
        } else if (pn >= 28 && pn < 32 && pm < 128) {
            const int ks = 2 * wc + (fq >> 1), khh = fq & 1;
#pragma unroll
            for (int ai = 0; ai < 2; ++ai)
#pragma unroll
                for (int m = 0; m < 4; ++m) {
                    const int r = rbase + ai * 128 + m * 16;
#pragma unroll
                    for (int bj = 0; bj < 2; ++bj) {
                        const int blk = ((pn - 28) * 2 + bj) * 8 + ks;
                        const f32x4 v0 = acc[ai][bj][m][0], v1 = acc[ai][bj][m][1];
                        u32x4 w; w.x = pk2(v0[0], v0[1]); w.y = pk2(v0[2], v0[3]); w.z = pk2(v1[0], v1[1]); w.w = pk2(v1[2], v1[3]);
                        *(u32x4*)(P + (size_t)((r & ~31) + (blk >> 1)) * INW + C_AK + (blk & 1) * 512 + ((r & 31) + 32 * khh) * 8) = w;
                    }
                }
        } else {
            const int act = (pn >= 16 && pn < 24) ? 1 : (pn >= 36 ? 2 : 0);
            const float sc = (pn >= 24 && pn < 28) ? 0.08838834764831845f : 1.f;
#pragma unroll
            for (int ai = 0; ai < 2; ++ai)
#pragma unroll
                for (int m = 0; m < 4; ++m) {
                    bf16_t* rowp = P + (size_t)(rbase + ai * 128 + m * 16) * INW + pn * 256 + wc * 32 + 8 * fq;
#pragma unroll
                    for (int bj = 0; bj < 2; ++bj) {
                        f32x4 v0 = acc[ai][bj][m][0] * sc, v1 = acc[ai][bj][m][1] * sc;
                        if (act) {
#pragma unroll
                            for (int e = 0; e < 4; ++e) { const float s0 = sigmoidf_(v0[e]), s1 = sigmoidf_(v1[e]); v0[e] = act == 1 ? v0[e] * s0 : s0; v1[e] = act == 1 ? v1[e] * s1 : s1; }
                        }
                        u32x4 w; w.x = pk2(v0[0], v0[1]); w.y = pk2(v0[2], v0[3]); w.z = pk2(v1[0], v1[1]); w.w = pk2(v1[2], v1[3]);
                        *(u32x4*)(rowp + bj * 128) = w;
                    }
                }
        }
        const bool isk = pn >= 28 && pn < 32, isav = pn >= 32 && pn < 36;
        if ((isk || isav) && (pm == 128 || (pm & 15) >= 14)) {
            float* ob; size_t rowidx0;
            if (pm == 128) { ob = out + (isk ? OFF_KS : OFF_VS); rowidx0 = 0; }
            else { ob = out + (isk ? OFF_KP : OFF_VP); rowidx0 = (size_t)(pm >> 4) * 512 + ((pm & 15) - 14) * 256; }
            const int cseg = (pn - (isk ? 28 : 32)) * 256 + wc * 32 + 8 * fq;
#pragma unroll
            for (int ai = 0; ai < 2; ++ai)
#pragma unroll
                for (int m = 0; m < 4; ++m) {
                    float* rowp = ob + (rowidx0 + ai * 128 + wr * 64 + m * 16 + fr) * 1024 + cseg;
#pragma unroll
                    for (int bj = 0; bj < 2; ++bj) { *(f32x4*)(rowp + bj * 128) = acc[ai][bj][m][0]; *(f32x4*)(rowp + bj * 128 + 4) = acc[ai][bj][m][1]; }
                }
        }
    }
};
template <int MODE> struct EpiMerge {
    static constexpr bool PERM = true, AFTER_DRAIN = false, TWICE = false;
    bf16_t* P; int pm0;
    DI void operator()(const f32x4 (&acc)[2][2][4][2], const Unit& u, int wr, int wc, int fr, int fq) const {
        const int rbase = (u.pm + pm0) * 256 + wr * 64 + fr, cb = u.pn * 256 + wc * 32 + 8 * fq;
#pragma unroll
        for (int ai = 0; ai < 2; ++ai) {
            u32x4 tv[4][2], gv[4][2];
#pragma unroll
            for (int m = 0; m < 4; ++m) {
                const bf16_t* rowp = P + (size_t)(rbase + ai * 128 + m * 16) * INW + cb;
#pragma unroll
                for (int bj = 0; bj < 2; ++bj) { tv[m][bj] = *(const u32x4*)(rowp + C_GR + bj * 128); if (MODE == 1) gv[m][bj] = *(const u32x4*)(rowp + C_GA + bj * 128); else gv[m][bj] = tv[m][bj]; }
            }
#pragma unroll
            for (int m = 0; m < 4; ++m) {
                bf16_t* rowp = P + (size_t)(rbase + ai * 128 + m * 16) * INW + cb;
#pragma unroll
                for (int bj = 0; bj < 2; ++bj) {
                    const u32x4 t = tv[m][bj], g = gv[m][bj];
                    const f32x4 a0 = acc[ai][bj][m][0], a1 = acc[ai][bj][m][1];
                    float o[8];
#pragma unroll
                    for (int q = 0; q < 4; ++q) {
                        const float glo = __uint_as_float(g[q] << 16), ghi = __uint_as_float(g[q] & 0xffff0000u);
                        const float alo = q < 2 ? a0[2 * q] : a1[2 * q - 4], ahi = q < 2 ? a0[2 * q + 1] : a1[2 * q - 3];
                        float lo = glo * alo, hi = ghi * ahi;
                        if (MODE == 1) { lo += __uint_as_float(t[q] << 16); hi += __uint_as_float(t[q] & 0xffff0000u); }
                        o[2 * q] = lo; o[2 * q + 1] = hi;
                    }
                    u32x4 w; w.x = pk2(o[0], o[1]); w.y = pk2(o[2], o[3]); w.z = pk2(o[4], o[5]); w.w = pk2(o[6], o[7]);
                    *(u32x4*)(rowp + C_GR + bj * 128) = w;
                }
            }
        }
    }
};
template <bool F32OUT> struct EpiSsq {
    static constexpr bool PERM = true, AFTER_DRAIN = false, TWICE = false;
    bf16_t* P; int ccol; float* ssq; int pm0;
    DI void operator()(const f32x4 (&acc)[2][2][4][2], const Unit& u, int wr, int wc, int fr, int fq) const {
        const int rbase = (u.pm + pm0) * 256 + wr * 64 + fr, cb = u.pn * 256 + wc * 32 + 8 * fq;
#pragma unroll
        for (int ai = 0; ai < 2; ++ai)
#pragma unroll
            for (int m = 0; m < 4; ++m) {
                const int r = rbase + ai * 128 + m * 16;
                float s = 0.f;
#pragma unroll
                for (int bj = 0; bj < 2; ++bj) {
                    const f32x4 v0 = acc[ai][bj][m][0], v1 = acc[ai][bj][m][1];
                    s += (v0[0] * v0[0] + v0[1] * v0[1]) + (v0[2] * v0[2] + v0[3] * v0[3]) + (v1[0] * v1[0] + v1[1] * v1[1]) + (v1[2] * v1[2] + v1[3] * v1[3]);
                    if (F32OUT) { float* rowp = (float*)(P + (size_t)r * INW) + cb + bj * 128; *(f32x4*)rowp = v0; *(f32x4*)(rowp + 4) = v1; }
                    else { u32x4 w; w.x = pk2(v0[0], v0[1]); w.y = pk2(v0[2], v0[3]); w.z = pk2(v1[0], v1[1]); w.w = pk2(v1[2], v1[3]); *(u32x4*)(P + (size_t)r * INW + ccol + cb + bj * 128) = w; }
                }
                s += __shfl_xor(s, 16); s += __shfl_xor(s, 32);
                if (fq == 0) ssq[(size_t)r * 32 + u.pn * 4 + wc] = s;
            }
    }
};
struct EpiPart {
    static constexpr bool PERM = true, AFTER_DRAIN = false, TWICE = false;
    float* part;
    DI void operator()(const f32x4 (&acc)[2][2][4][2], const Unit& u, int wr, int wc, int fr, int fq) const {
        float* base = part + ((size_t)u.pm * 256 + wr * 64 + fr) * DM + u.pn * 256 + wc * 32 + 8 * fq;
#pragma unroll
        for (int ai = 0; ai < 2; ++ai)
#pragma unroll
            for (int m = 0; m < 4; ++m) {
                float* rowp = base + (size_t)(ai * 128 + m * 16) * DM;
#pragma unroll
                for (int bj = 0; bj < 2; ++bj) { *(f32x4*)(rowp + bj * 128) = acc[ai][bj][m][0]; *(f32x4*)(rowp + bj * 128 + 4) = acc[ai][bj][m][1]; }
            }
    }
};
#ifndef EPI_TWICE_UP
#define EPI_TWICE_UP false
#endif
struct EpiUp {
    static constexpr bool PERM = true, AFTER_DRAIN = false, TWICE = EPI_TWICE_UP;
    bf16_t* P; float* out; int pm0;
    DI void operator()(const f32x4 (&acc)[2][2][4][2], const Unit& u, int wr, int wc, int fr, int fq) const {
        const int rbase = (u.pm + pm0) * 256 + wr * 64 + fr, cb = u.pn * 256 + wc * 32 + 8 * fq;
#pragma unroll
        for (int ai = 0; ai < 2; ++ai)
#pragma unroll
            for (int m = 0; m < 4; ++m) {
                const int r = rbase + ai * 128 + m * 16;
                float* cst = nullptr;
                if (r < MP) { const int t = r & 4095; if (t >= 4094) cst = out + OFF_CP + ((size_t)(r >> 12) * 2 + (t - 4094)) * UPW; }
                else { const int t = r & 15; if (t >= 14) cst = out + OFF_CS + ((size_t)((r - MP) >> 4) * 2 + (t - 14)) * UPW; }
#pragma unroll
                for (int bj = 0; bj < 2; ++bj) {
                    const f32x4 v0 = acc[ai][bj][m][0], v1 = acc[ai][bj][m][1];
                    u32x4 w; w.x = pk2(v0[0], v0[1]); w.y = pk2(v0[2], v0[3]); w.z = pk2(v1[0], v1[1]); w.w = pk2(v1[2], v1[3]);
                    *(u32x4*)(P + (size_t)r * INW + C_UP + cb + bj * 128) = w;
                    if (cst) { *(f32x4*)(cst + cb + bj * 128) = v0; *(f32x4*)(cst + cb + bj * 128 + 4) = v1; }
                }
            }
    }
};

constexpr int TR_RS = 132, TR_BYTES = 32 * TR_RS * 4;
DI void transpose_item(const float* W, int K, int N, bf16_t* WT, LAS float* scr, int item, int lane, bool permq) {
    const int nblk = N / 128, kb = item / nblk, nb = item % nblk, k0 = 32 * kb, n0 = 128 * nb;
    const int c = lane & 31, kh = lane >> 5;
    const int pc = (permq && n0 < 2048) ? (32 * ((c >> 2) & 3) + 8 * (c & 3) + 4 * (c >> 4)) : 4 * c;
    const float* src = W + (size_t)(k0 + kh) * N + n0 + 4 * c;
    f32x4 v[16];
#pragma unroll
    for (int i = 0; i < 16; ++i) v[i] = *(const f32x4*)(src + (size_t)(2 * i) * N);
#pragma unroll
    for (int i = 0; i < 16; ++i) *(LAS f32x4*)(scr + (2 * i + kh) * TR_RS + pc) = v[i];
    asm volatile("s_waitcnt lgkmcnt(0)" ::: "memory");
    const int kc = lane & 3;
#pragma unroll
    for (int jj = 0; jj < 8; ++jj) { const int n = (lane >> 2) + 16 * jj; const LAS float* s = scr + (8 * kc) * TR_RS + n;
        u32x4 o; o.x = pk2(s[0 * TR_RS], s[1 * TR_RS]); o.y = pk2(s[2 * TR_RS], s[3 * TR_RS]); o.z = pk2(s[4 * TR_RS], s[5 * TR_RS]); o.w = pk2(s[6 * TR_RS], s[7 * TR_RS]);
        *(u32x4*)(WT + (size_t)(n0 + n) * K + k0 + 8 * kc) = o; }
    asm volatile("s_waitcnt lgkmcnt(0)" ::: "memory");
}
DI void mod_item(const float* cp, const float* cs, const float* wada, float* modp, LAS float* scr, int item, int lane) {
    const int s = item / 48, cb = item % 48, k0 = s * 128;
    for (int i = lane; i < 24 * 128; i += 64) { const int r = i >> 7, k = i & 127; const float c = r < 8 ? cp[r * DM + k0 + k] : cs[(r - 8) * DM + k0 + k]; scr[i] = c * sigmoidf_(c); }
    asm volatile("s_waitcnt lgkmcnt(0)" ::: "memory");
    f32x4 acc[24];
#pragma unroll
    for (int r = 0; r < 24; ++r) acc[r] = (f32x4){0.f, 0.f, 0.f, 0.f};
    const float* wp = wada + (size_t)k0 * MODW + cb * 256 + lane * 4;
    for (int k = 0; k < 128; k += 16) {
        f32x4 w[16];
#pragma unroll
        for (int i = 0; i < 16; ++i) w[i] = *(const f32x4*)(wp + (size_t)(k + i) * MODW);
#pragma unroll
        for (int r = 0; r < 24; ++r) {
#pragma unroll
            for (int i4 = 0; i4 < 4; ++i4) { const f32x4 c4 = *(const LAS f32x4*)(scr + r * 128 + k + 4 * i4); acc[r] += w[4 * i4] * c4.x + w[4 * i4 + 1] * c4.y + w[4 * i4 + 2] * c4.z + w[4 * i4 + 3] * c4.w; }
        }
    }
#pragma unroll
    for (int r = 0; r < 24; ++r) *(f32x4*)(modp + ((size_t)s * 24 + r) * MODW + cb * 256 + lane * 4) = acc[r];
    asm volatile("s_waitcnt lgkmcnt(0)" ::: "memory");
}
DI void norm_mod_row(const float* xrow, const float* g, const float* sc, const float* sh, bf16_t* orow, int lane) {
    f32x4 v[8]; float s = 0.f;
#pragma unroll
    for (int j = 0; j < 8; ++j) { v[j] = *(const f32x4*)(xrow + 4 * lane + 256 * j); s += (v[j].x * v[j].x + v[j].y * v[j].y) + (v[j].z * v[j].z + v[j].w * v[j].w); }
    const float rstd = rsqrtf(wave_sum(s) * (1.f / DM) + EPS);
#pragma unroll
    for (int j = 0; j < 8; ++j) {
        const int c = 4 * lane + 256 * j;
        const f32x4 gg = *(const f32x4*)(g + c), a = *(const f32x4*)(sc + c), b = *(const f32x4*)(sh + c);
        const f32x4 o = (v[j] * rstd) * gg * (a + 1.f) + b;
        u32x2 w; w.x = pk2(o.x, o.y); w.y = pk2(o.z, o.w); *(u32x2*)(orow + c) = w;
    }
}

template <bool DRY> DI void att_unit(bf16_t* P, const LAS float* bl, int unit, int lane) {
    asm volatile("" : "+v"(lane));
    const int qh = unit & 1, c = (unit >> 1) & 63, h = (unit >> 7) & 7, b = unit >> 10;
    bl += h * 257;
    const int r32 = lane & 31, hh = lane >> 5;
    const size_t rowb = (size_t)b * SEQ;
    const int t0 = c * 64 + qh * 32, qpos = t0 + r32;
    const bf16_t* qrow = P + (rowb + t0 + r32) * INW + C_AQ + 128 * h + 8 * hh;
    bf16x8 qf[8];
#pragma unroll
    for (int ks = 0; ks < 8; ++ks) qf[ks] = *(const bf16x8*)(qrow + 16 * ks);
    f32x16 o[4];
#pragma unroll
    for (int d = 0; d < 4; ++d)
#pragma unroll
        for (int i = 0; i < 16; ++i) o[d][i] = 0.f;
    float mrun = -1e30f, lrun = 0.f;
    const int k0 = c * 64 - 512 < 0 ? 0 : c * 64 - 512, k1 = c * 64 + 64;
    bf16x8 kf[8];
    {
#pragma unroll
        for (int ks = 0; ks < 8; ++ks) kf[ks] = *(const bf16x8*)(P + (rowb + k0 + ((h * 8 + ks) >> 1)) * INW + C_AK + ((h * 8 + ks) & 1) * 512 + lane * 8); }
    bf16x8 vf[2][4];
#pragma unroll
    for (int s2 = 0; s2 < 2; ++s2)
#pragma unroll
        for (int d = 0; d < 4; ++d) vf[s2][d] = *(const bf16x8*)(P + (rowb + k0 + 16 * s2 + ((h * 4 + d) >> 1)) * INW + C_AV + ((h * 4 + d) & 1) * 512 + lane * 8);
    for (int key0 = k0; key0 < k1; key0 += 32) {
        f32x16 s;
#pragma unroll
        for (int i = 0; i < 16; ++i) s[i] = 0.f;
#pragma unroll
        for (int ks = 0; ks < 8; ++ks) s = MFMA32(kf[ks], qf[ks], s);
        {
            const int kn0 = key0 + 32 < k1 ? key0 + 32 : key0;
#pragma unroll
            for (int ks = 0; ks < 8; ++ks) kf[ks] = *(const bf16x8*)(P + (rowb + kn0 + ((h * 8 + ks) >> 1)) * INW + C_AK + ((h * 8 + ks) & 1) * 512 + lane * 8); }
        float mx = -1e30f;
        if (key0 + 159 <= t0) {
            const float b0 = bl[0];
#pragma unroll
            for (int i = 0; i < 16; ++i) { s[i] += b0; mx = fmaxf(mx, s[i]); }
        } else {
#pragma unroll
            for (int i = 0; i < 16; ++i) { int idx = key0 + crow(i, hh) - qpos + 128; idx = idx < 0 ? 0 : idx; s[i] += bl[idx]; mx = fmaxf(mx, s[i]); }
        }
        mx = fmaxf(mx, __shfl_xor(mx, 32));
        if (__builtin_amdgcn_ballot_w64(mx - mrun > 8.f) != 0ull) {
            const float mnew = fmaxf(mrun, mx), alpha = __expf(mrun - mnew);
            lrun *= alpha; mrun = mnew;
#pragma unroll
            for (int d = 0; d < 4; ++d)
#pragma unroll
                for (int i = 0; i < 16; ++i) o[d][i] *= alpha;
        }
        float psum = 0.f;
#pragma unroll
        for (int i = 0; i < 16; ++i) { const float p = __expf(s[i] - mrun); psum += p; s[i] = p; }
        lrun += psum;
#pragma unroll
        for (int s2 = 0; s2 < 2; ++s2) {
            const bf16x8 xs = pack_step(s, s2);
#pragma unroll
            for (int d = 0; d < 4; ++d) o[d] = MFMA32(vf[s2][d], xs, o[d]);
        }
        {
            const int kn0 = key0 + 32 < k1 ? key0 + 32 : key0;
#pragma unroll
            for (int s2 = 0; s2 < 2; ++s2)
#pragma unroll
                for (int d = 0; d < 4; ++d) vf[s2][d] = *(const bf16x8*)(P + (rowb + kn0 + 16 * s2 + ((h * 4 + d) >> 1)) * INW + C_AV + ((h * 4 + d) & 1) * 512 + lane * 8);
        }
    }
    const float inv = 1.f / (lrun + __shfl_xor(lrun, 32));
    bf16_t* orow = P + (rowb + t0 + r32) * INW + C_AQ + 128 * h + 4 * hh;
    if (!DRY || lrun < -1.f)
#pragma unroll
    for (int d = 0; d < 4; ++d)
#pragma unroll
        for (int g = 0; g < 4; ++g) { u32x2 w; w.x = pk2(o[d][4 * g] * inv, o[d][4 * g + 1] * inv); w.y = pk2(o[d][4 * g + 2] * inv, o[d][4 * g + 3] * inv); *(u32x2*)(orow + 32 * d + 8 * g) = w; }
}

constexpr int RT_RS = 272, RT_QLB = 64 * RT_RS, RT_BUFB = 2 * RT_QLB + 16384, RT_ORS = 528, RT_LDS0 = 8448;
DI void ret_stage_qk(LAS unsigned char* buf, const u32x4 (&qn)[2], const u32x4 (&kn)[2], int tid, float lg) {
#pragma unroll
    for (int it = 0; it < 2; ++it) {
        const int piece = tid + 512 * it, m = piece >> 4, ch = piece & 15;
        *(LAS u32x4*)(buf + m * RT_RS + ch * 16) = qn[it];
        *(LAS u32x4*)(buf + RT_QLB + m * RT_RS + ch * 16) = kn[it];
        const float dk = __builtin_amdgcn_exp2f((float)(63 - m) * lg);
        const int m16 = m >> 4, t4 = m & 15, khh = (t4 >> 2) & 1, j = ((t4 >> 3) << 2) | (t4 & 3), db = ch >> 2, dl0 = (ch & 3) * 8;
        LAS bf16_t* dst = (LAS bf16_t*)(buf + 2 * RT_QLB) + ((((m16 * 4 + db) * 2 + khh) * 32 + dl0) * 8 + j);
#pragma unroll
        for (int q = 0; q < 4; ++q) {
            dst[(2 * q) * 8] = (bf16_t)f2bf(__uint_as_float(kn[it][q] << 16) * dk);
            dst[(2 * q + 1) * 8] = (bf16_t)f2bf(__uint_as_float(kn[it][q] & 0xffff0000u) * dk);
        }
    }
}
template <bool DRY> DI void ret_prompt_unit(bf16_t* P, float* out, int b, int h, LAS unsigned char* lds0, int tid) {
    asm volatile("" : "+v"(tid));
    LAS unsigned char* lds = lds0 + RT_LDS0;
    LAS unsigned char* XA = lds + 2 * RT_BUFB;
    const int w = __builtin_amdgcn_readfirstlane(tid >> 6);
    const float lg = log2f(1.f - exp2f(-5.f - (float)h));
    const float dsc = __builtin_amdgcn_exp2f(64.f * lg), g1 = __builtin_amdgcn_exp2f(lg), g8 = __builtin_amdgcn_exp2f(8.f * lg);
    f32x16 S[4];
#pragma unroll
    for (int d = 0; d < 4; ++d)
#pragma unroll
        for (int i = 0; i < 16; ++i) S[d][i] = 0.f;
    bf16x8 vf[4];
    {
        const size_t R0 = (size_t)b * SEQ;
        const int lane = tid & 63, r32 = lane & 31, hh = lane >> 5;
        u32x4 qn[2], kn[2];
#pragma unroll
        for (int it = 0; it < 2; ++it) { const int piece = tid + 512 * it, m = piece >> 4, ch = piece & 15;
            qn[it] = *(const u32x4*)(P + (R0 + m) * INW + C_RQ + 128 * h + 8 * ch); kn[it] = *(const u32x4*)(P + (R0 + m) * INW + C_RK + 128 * h + 8 * ch); }
#pragma unroll
        for (int m16 = 0; m16 < 4; ++m16) vf[m16] = *(const bf16x8*)(P + (R0 + 16 * m16 + hh * 8 + (r32 >> 2)) * INW + C_RV + 256 * h + 32 * w + (r32 & 3) * 8);
        __syncthreads();
        ret_stage_qk(lds, qn, kn, tid, lg);
        __syncthreads();
    }
    for (int c = 0; c < 64; ++c) {
        asm volatile("" : "+v"(tid));
        const int lane = tid & 63, r32 = lane & 31, hh = lane >> 5;
        const size_t R0 = (size_t)b * SEQ + 64 * c, R1 = R0 + 64;
        LAS unsigned char* cur = lds + (c & 1) * RT_BUFB; LAS unsigned char* nxt = lds + ((c & 1) ^ 1) * RT_BUFB;
        const LAS unsigned char* QL = cur; const LAS unsigned char* KL = cur + RT_QLB; const LAS bf16_t* KD = (const LAS bf16_t*)(cur + 2 * RT_QLB);
        {
            const int tr = w >> 1, tc0 = 2 * (w & 1), i16 = lane & 15, kq = lane >> 4;
            f32x4 xt[2] = {(f32x4){0.f, 0.f, 0.f, 0.f}, (f32x4){0.f, 0.f, 0.f, 0.f}};
            const LAS unsigned char* kp = KL + (16 * tr + i16) * RT_RS + 16 * kq;
            const LAS unsigned char* qp0 = QL + (16 * tc0 + i16) * RT_RS + 16 * kq;
#pragma unroll
            for (int ks = 0; ks < 4; ++ks) {
                const bf16x8 kf = *(const LAS bf16x8*)(kp + 64 * ks);
#pragma unroll
                for (int tt = 0; tt < 2; ++tt) { const bf16x8 qf = *(const LAS bf16x8*)(qp0 + tt * 16 * RT_RS + 64 * ks); xt[tt] = __builtin_amdgcn_mfma_f32_16x16x32_bf16(kf, qf, xt[tt], 0, 0, 0); }
            }
#pragma unroll
            for (int tt = 0; tt < 2; ++tt) {
                const int tc = tc0 + tt; const float nm = (float)((16 * tc + i16) - (16 * tr + 4 * kq));
                float xv[4];
#pragma unroll
                for (int e = 0; e < 4; ++e) xv[e] = xt[tt][e] * __builtin_amdgcn_exp2f(fabsf(nm - (float)e) * lg);
                u32x2 pk; pk.x = pk2(xv[0], xv[1]); pk.y = pk2(xv[2], xv[3]);
                *(LAS u32x2*)(XA + (((tc >> 1) * 4 + tr) * 64 + ((tc & 1) * 16 + i16) + 32 * (kq & 1)) * 16 + (kq >> 1) * 8) = pk;
            }
        }
        f32x16 O[2];
#pragma unroll
        for (int nb = 0; nb < 2; ++nb)
#pragma unroll
            for (int i = 0; i < 16; ++i) O[nb][i] = 0.f;
#pragma unroll
        for (int db = 0; db < 4; ++db)
#pragma unroll
            for (int s = 0; s < 2; ++s) {
                const bf16x8 xs = pack_step(S[db], s);
#pragma unroll
                for (int nb = 0; nb < 2; ++nb) {
                    const LAS unsigned char* qp = QL + (32 * nb + r32) * RT_RS + (32 * db + 16 * s + 4 * hh) * 2;
                    const u32x2 lo = *(const LAS u32x2*)qp, hi = *(const LAS u32x2*)(qp + 16);
                    u32x4 pq; pq.x = lo.x; pq.y = lo.y; pq.z = hi.x; pq.w = hi.y;
                    O[nb] = MFMA32(__builtin_bit_cast(bf16x8, pq), xs, O[nb]);
                }
                if (s == 1) asm volatile("" ::: "memory");
            }
        {
            float fg = __builtin_amdgcn_exp2f((float)(4 * hh + 1) * lg);
#pragma unroll
            for (int nb = 0; nb < 2; ++nb)
#pragma unroll
                for (int g = 0; g < 4; ++g) {
                    float fe = fg;
#pragma unroll
                    for (int e = 0; e < 4; ++e) { O[nb][4 * g + e] *= fe; fe *= g1; }
                    fg *= g8;
                }
        }
        u32x4 qn[2], kn[2];
#pragma unroll
        for (int it = 0; it < 2; ++it) { const int piece = tid + 512 * it, m = piece >> 4, ch = piece & 15;
            qn[it] = *(const u32x4*)(P + (R1 + m) * INW + C_RQ + 128 * h + 8 * ch); kn[it] = *(const u32x4*)(P + (R1 + m) * INW + C_RK + 128 * h + 8 * ch); }
        __syncthreads();
#pragma unroll
        for (int nb = 0; nb < 2; ++nb)
#pragma unroll
            for (int m16 = 0; m16 < 4; ++m16) { const bf16x8 xa = *(const LAS bf16x8*)(XA + ((nb * 4 + m16) * 64 + lane) * 16); O[nb] = MFMA32(xa, vf[m16], O[nb]); }
#pragma unroll
        for (int db = 0; db < 4; ++db) {
#pragma unroll
            for (int i = 0; i < 16; ++i) S[db][i] *= dsc;
#pragma unroll
            for (int m16 = 0; m16 < 4; ++m16) { const bf16x8 kd = *(const LAS bf16x8*)(KD + ((m16 * 4 + db) * 64 + lane) * 8); S[db] = MFMA32(kd, vf[m16], S[db]); }
        }
        asm volatile("" ::: "memory");
#pragma unroll
        for (int m16 = 0; m16 < 4; ++m16) vf[m16] = *(const bf16x8*)(P + (R1 + 16 * m16 + hh * 8 + (r32 >> 2)) * INW + C_RV + 256 * h + 32 * w + (r32 & 3) * 8);
        const int on = tid >> 3, oseg = tid & 7;
        bf16_t* orow = P + (R0 + on) * INW + 256 * h + 32 * oseg;
        u32x4 gr[4];
#pragma unroll
        for (int j = 0; j < 4; ++j) gr[j] = *(const u32x4*)(orow + C_RG + 8 * j);
        __syncthreads();
        LAS bf16_t* olb = (LAS bf16_t*)(cur + (4 * hh) * RT_ORS) + 32 * w + r32;
#pragma unroll
        for (int nb = 0; nb < 2; ++nb)
#pragma unroll
            for (int i = 0; i < 16; ++i) {
                constexpr int dummy = 0; (void)dummy;
                const int cn = 32 * nb + (i & 3) + 8 * (i >> 2);
                olb[cn * (RT_ORS / 2)] = (bf16_t)f2bf(O[nb][i]);
            }
        ret_stage_qk(nxt, qn, kn, tid, lg);
        __syncthreads();
        {
            u32x4 ovs[4]; float sq = 0.f;
#pragma unroll
            for (int j = 0; j < 4; ++j) { ovs[j] = *(const LAS u32x4*)(cur + on * RT_ORS + oseg * 64 + j * 16);
#pragma unroll
                for (int q = 0; q < 4; ++q) { const float lo = __uint_as_float(ovs[j][q] << 16), hi = __uint_as_float(ovs[j][q] & 0xffff0000u); sq += lo * lo + hi * hi; } }
            sq += __shfl_xor(sq, 1); sq += __shfl_xor(sq, 2); sq += __shfl_xor(sq, 4);
            const float rstd = rsqrtf(sq * (1.f / 256.f) + EPS);
#pragma unroll
            for (int j = 0; j < 4; ++j) {
                const u32x4 ov = ovs[j];
                u32x4 wv4;
#pragma unroll
                for (int q = 0; q < 4; ++q) {
                    const float lo = __uint_as_float(ov[q] << 16) * rstd * __uint_as_float(gr[j][q] << 16);
                    const float hi = __uint_as_float(ov[q] & 0xffff0000u) * rstd * __uint_as_float(gr[j][q] & 0xffff0000u);
                    wv4[q] = pk2(lo, hi);
                }
                if (!DRY || dsc < 0.f) *(u32x4*)(orow + C_RV + 8 * j) = wv4;
            }
        }
    }
    const int lane = tid & 63, r32 = lane & 31, hh = lane >> 5;
    float* so = out + OFF_RP + ((size_t)(b * 8 + h) * 128) * 256 + 32 * w + r32;
#pragma unroll
    for (int db = 0; db < 4; ++db)
#pragma unroll
        for (int i = 0; i < 16; ++i) if (!DRY || dsc < 0.f) so[(size_t)(32 * db + crow(i, hh)) * 256] = S[db][i];
    __syncthreads();
}

DI void ret_sample_unit(bf16_t* P, const float* state_in, float* out, int sb, int h, LAS unsigned char* lds, int tid) {
    asm volatile("" : "+v"(tid));
    LAS float* qs = (LAS float*)lds; LAS float* ks = qs + 2048; LAS float* vs = ks + 2048; LAS float* As = vs + 4096; LAS float* part = As + 256;
    const size_t R0 = (size_t)MP + 16 * sb;
    const float lg = log2f(1.f - exp2f(-5.f - (float)h));
    __syncthreads();
    for (int i = tid; i < 2048; i += 512) { const int t = i >> 7, d = i & 127; qs[i] = bf2f(P[(R0 + t) * INW + C_RQ + 128 * h + d]); ks[i] = bf2f(P[(R0 + t) * INW + C_RK + 128 * h + d]); }
    for (int i = tid; i < 4096; i += 512) { const int t = i >> 8, e = i & 255; vs[i] = bf2f(P[(R0 + t) * INW + C_RV + 256 * h + e]); }
    __syncthreads();
    if (tid < 256) { const int n = tid >> 4, m = tid & 15; float a = 0.f;
#pragma unroll 4
        for (int d = 0; d < 128; ++d) a += qs[n * 128 + d] * ks[m * 128 + d]; const int dd = n > m ? n - m : m - n; As[tid] = a * exp2f((float)dd * lg); }
    __syncthreads();
    const int e = tid & 255, hf = tid >> 8;
    const float* S0 = state_in + ((size_t)(sb * 8 + h) * 128) * 256 + e;
    float o[8];
#pragma unroll
    for (int i = 0; i < 8; ++i) o[i] = 0.f;
#pragma unroll 4
    for (int d = 0; d < 128; ++d) { const float s = S0[(size_t)d * 256];
#pragma unroll
        for (int i = 0; i < 8; ++i) o[i] += qs[(8 * hf + i) * 128 + d] * s; }
    float vreg[16];
#pragma unroll
    for (int m = 0; m < 16; ++m) vreg[m] = vs[m * 256 + e];
#pragma unroll
    for (int i = 0; i < 8; ++i) { const int n = 8 * hf + i; float a = o[i] * exp2f((float)(n + 1) * lg);
#pragma unroll
        for (int m = 0; m < 16; ++m) a += As[n * 16 + m] * vreg[m];
        o[i] = a; }
    { const float d16 = exp2f(16.f * lg); float* so = out + OFF_RS + ((size_t)(sb * 8 + h) * 128) * 256 + e;
#pragma unroll
      for (int m = 0; m < 16; ++m) vreg[m] *= exp2f((float)(15 - m) * lg);
#pragma unroll 2
      for (int d = 64 * hf; d < 64 * hf + 64; ++d) { float a = d16 * S0[(size_t)d * 256];
#pragma unroll
          for (int m = 0; m < 16; ++m) a += ks[m * 128 + d] * vreg[m];
          so[(size_t)d * 256] = a; } }
    const int wv = tid >> 6, lane = tid & 63;
#pragma unroll
    for (int i = 0; i < 8; ++i) { const float q = wave_sum(o[i] * o[i]); if (lane == 0) part[(8 * hf + i) * 4 + (wv & 3)] = q; }
    __syncthreads();
#pragma unroll
    for (int i = 0; i < 8; ++i) { const int n = 8 * hf + i; const float rstd = rsqrtf(((part[n * 4] + part[n * 4 + 1]) + (part[n * 4 + 2] + part[n * 4 + 3])) * (1.f / 256.f) + EPS);
        bf16_t* rp = P + (R0 + n) * INW + 256 * h + e; rp[C_RV] = (bf16_t)f2bf(o[i] * rstd * bf2f(rp[C_RG])); }
    __syncthreads();
}
DI void att_sample_unit(bf16_t* P, const float* ck, const float* cv, const float* relb, int sb, int h, LAS unsigned char* lds, int tid) {
    asm volatile("" : "+v"(tid));
    LAS float* qs = (LAS float*)lds; LAS float* sc = qs + 2048;
    const size_t R0 = (size_t)MP + 16 * sb;
    __syncthreads();
    for (int i = tid; i < 2048; i += 512) { const int t = i >> 7, d = i & 127; qs[i] = bf2f(P[(R0 + t) * INW + C_AQ + 128 * h + d]); }
    __syncthreads();
    for (int key = tid; key < 528; key += 512) {
        float acc[16];
#pragma unroll
        for (int q = 0; q < 16; ++q) acc[q] = 0.f;
        if (key < 512) {
            const float* kr = ck + (((size_t)sb * 512 + key) * 8 + h) * 128;
            for (int d = 0; d < 128; d += 4) { const f32x4 kv = *(const f32x4*)(kr + d);
#pragma unroll
                for (int q = 0; q < 16; ++q) { const f32x4 qq = *(const LAS f32x4*)(qs + q * 128 + d); acc[q] += (kv.x * qq.x + kv.y * qq.y) + (kv.z * qq.z + kv.w * qq.w); } }
        } else {
            const bf16_t* kr = P + (R0 + key - 512) * INW + C_AK + 128 * h;
            for (int d = 0; d < 128; ++d) { const float kv = bf2f(kr[d]);
#pragma unroll
                for (int q = 0; q < 16; ++q) acc[q] += kv * qs[q * 128 + d]; }
        }
        const int kpos = key < 512 ? 3584 + key : 4096 + (key - 512);
#pragma unroll
        for (int q = 0; q < 16; ++q) { int rel = kpos - (4096 + q); rel = rel < -128 ? -128 : (rel > 128 ? 128 : rel); sc[q * 528 + key] = acc[q] + relb[h * 257 + rel + 128]; }
    }
    __syncthreads();
    { const int wv = tid >> 6, lane = tid & 63;
      for (int q = 2 * wv; q < 2 * wv + 2; ++q) {
          float mx = -1e30f; for (int k = lane; k < 528; k += 64) mx = fmaxf(mx, sc[q * 528 + k]);
#pragma unroll
          for (int o = 1; o < 64; o <<= 1) mx = fmaxf(mx, __shfl_xor(mx, o));
          float sm = 0.f; for (int k = lane; k < 528; k += 64) { const float p = __expf(sc[q * 528 + k] - mx); sc[q * 528 + k] = p; sm += p; }
          sm = wave_sum(sm); const float inv = 1.f / sm;
          for (int k = lane; k < 528; k += 64) sc[q * 528 + k] *= inv;
      } }
    __syncthreads();
    { const int d4 = (tid & 31) * 4, q = tid >> 5;
      f32x4 a = (f32x4){0.f, 0.f, 0.f, 0.f};
      const float* vr = cv + ((size_t)sb * 512 * 8 + h) * 128 + d4;
      for (int k = 0; k < 512; ++k) { const f32x4 v = *(const f32x4*)(vr + (size_t)k * 1024); a += v * sc[q * 528 + k]; }
      for (int k = 0; k < 16; ++k) { const bf16_t* vp = P + (R0 + k) * INW + C_AV + 128 * h + d4; const float p = sc[q * 528 + 512 + k];
          a.x += bf2f(vp[0]) * p; a.y += bf2f(vp[1]) * p; a.z += bf2f(vp[2]) * p; a.w += bf2f(vp[3]) * p; }
      u32x2 w; w.x = pk2(a.x, a.y); w.y = pk2(a.z, a.w);
      *(u32x2*)(P + (R0 + q) * INW + C_AQ + 128 * h + d4) = w; }
    __syncthreads();
}

#define XB_TMO      128
#define XB_XCNT(j)  (256  + 64 * (j))
#define XB_XSUB(j)  (1280 + 64 * (j))
#define XB_XGEN(j)  (2304 + 64 * (j))
#define XB_TOP      3328
#define XB_TOPGEN   3392
#define XCD_BAR_WORDS 3456
#define XB_SPIN_CAP (1u << 18)

__device__ __forceinline__ unsigned xb_ld(unsigned* p)              { return __hip_atomic_load(p, __ATOMIC_RELAXED, __HIP_MEMORY_SCOPE_AGENT); }
__device__ __forceinline__ unsigned xb_add(unsigned* p, unsigned v) { return __hip_atomic_fetch_add(p, v, __ATOMIC_RELAXED, __HIP_MEMORY_SCOPE_AGENT); }
__device__ __forceinline__ unsigned xb_xcc_id() { return (unsigned)__builtin_amdgcn_s_getreg((3 << 11) | 20) & 0xFu; }
#define XB_SPIN(cond, bar) do { unsigned _sp = 0; while (cond) { __builtin_amdgcn_s_sleep(1); \
    if ((++_sp & 255u) == 0u) { if (xb_ld(&(bar)[XB_TMO])) break; if (_sp > XB_SPIN_CAP) { atomicAdd(&(bar)[XB_TMO], 1u); break; } } } } while (0)

struct XcdBarrier {
    unsigned* bar; unsigned x;
    volatile LAS unsigned* st;
};

__device__ __forceinline__ XcdBarrier xcd_barrier_post(unsigned* bar, volatile LAS unsigned* st) {
    XcdBarrier b; b.bar = bar; b.x = xb_xcc_id(); b.st = st;
    if (threadIdx.x == 0) (void)xb_add(&bar[XB_XCNT(b.x)], 1u);
    return b;
}
__device__ __forceinline__ void xcd_barrier_complete(unsigned* bar, unsigned x, unsigned& nloc, unsigned& nx) {
    const unsigned G = gridDim.x * gridDim.y * gridDim.z;
    unsigned sum, cnt, mine, sp = 0u;
    for (;;) {
        sum = 0u; cnt = 0u; mine = 0u;
#pragma unroll
        for (unsigned j = 0; j < 16; ++j) { const unsigned c = xb_ld(&bar[XB_XCNT(j)]); sum += c; cnt += (c > 0u) ? 1u : 0u; mine = (j == x) ? c : mine; }
        if (sum == G) break;
        __builtin_amdgcn_s_sleep(1);
        if ((++sp & 255u) == 0u) { if (xb_ld(&bar[XB_TMO])) break; if (sp > XB_SPIN_CAP) { atomicAdd(&bar[XB_TMO], 1u); break; } }
    }
    nloc = mine > 0u ? mine : 1u; nx = cnt > 0u ? cnt : 1u;
}

__device__ __forceinline__ void xcd_barrier(const XcdBarrier& b) {
    asm volatile("s_waitcnt vmcnt(0)" ::: "memory");
    __syncthreads();
    if (threadIdx.x == 0) {
        unsigned* bar = b.bar;
        __builtin_amdgcn_s_waitcnt(0);
        unsigned nloc = b.st[0], nx = b.st[1];
        if (nloc == 0u) { xcd_barrier_complete(bar, b.x, nloc, nx); b.st[0] = nloc; b.st[1] = nx; }
        const unsigned old = xb_add(&bar[XB_XSUB(b.x)], 1u);
        const unsigned gen = old / nloc;
        if (old + 1u == (gen + 1u) * nloc) {
            __builtin_amdgcn_fence(__ATOMIC_RELEASE, "agent");
            asm volatile("s_waitcnt vmcnt(0)" ::: "memory");
            const unsigned og = xb_add(&bar[XB_TOP], 1u);
            const unsigned tg = og / nx;
            if (og + 1u == (tg + 1u) * nx) xb_add(&bar[XB_TOPGEN], 1u);
            else XB_SPIN(xb_ld(&bar[XB_TOPGEN]) == tg, bar);
            __builtin_amdgcn_fence(__ATOMIC_ACQUIRE, "agent");
            xb_add(&bar[XB_XGEN(b.x)], 1u);
            asm volatile("s_waitcnt vmcnt(0)" ::: "memory");
        } else {
            XB_SPIN(xb_ld(&bar[XB_XGEN(b.x)]) == gen, bar);
            __builtin_amdgcn_fence(__ATOMIC_ACQUIRE, "agent");
            asm volatile("s_waitcnt vmcnt(0)" ::: "memory");
        }
    }
    __syncthreads();
}


struct Ctx { bf16_t *P, *HS, *WBR, *WBA, *WOUT, *WUP, *WDN; float *out, *Y, *SSQ, *MOD, *PART; const float *x_p, *x_s, *g_post1, *g_pre2, *g_post2, *conv_w, *conv_b, *state_conv; unsigned* subbar; LAS unsigned char* lds; XcdBarrier xbar; };
DI void sub_barrier(unsigned* cnt, unsigned nblk, unsigned& gen) {
    asm volatile("s_waitcnt vmcnt(0)" ::: "memory");
    __syncthreads();
    ++gen;
    if (threadIdx.x == 0) {
        __builtin_amdgcn_fence(__ATOMIC_RELEASE, "agent");
        asm volatile("s_waitcnt vmcnt(0)" ::: "memory");
        (void)__hip_atomic_fetch_add(cnt, 1u, __ATOMIC_RELAXED, __HIP_MEMORY_SCOPE_AGENT);
        const unsigned want = gen * nblk; unsigned sp = 0;
        while (__hip_atomic_load(cnt, __ATOMIC_RELAXED, __HIP_MEMORY_SCOPE_AGENT) < want) { __builtin_amdgcn_s_sleep(2); if (++sp > (1u << 22)) break; }
        __builtin_amdgcn_fence(__ATOMIC_ACQUIRE, "agent");
        asm volatile("s_waitcnt vmcnt(0)" ::: "memory");
    }
    __syncthreads();
}
DI bf16_t* h_row(const Ctx& c, int r) { return r < 16384 ? c.P + (size_t)(r + 16384) * INW + C_H : (r < 32768 ? c.P + (size_t)(r - 16384) * INW + C_H : c.HS + (size_t)(r - 32768) * INW); }
template <bool SUB> DI void post_mixer(const Ctx& c, int tile_lo, int ntile, int G, int cb, unsigned& sgen) {
#define PM_SYNC() do { if (SUB) sub_barrier(c.subbar, (unsigned)G, sgen); else xcd_barrier(c.xbar); } while (0)
#define PM_TID() int tid = threadIdx.x; asm volatile("" : "+v"(tid)); const int lane = tid & 63, wv = __builtin_amdgcn_readfirstlane(tid >> 6), gw = cb * 8 + wv; (void)lane; (void)gw
    bf16_t* P = c.P; LAS unsigned char* lds = c.lds;
    const int NGW = G * 8, row_lo = tile_lo * 256, row_hi = row_lo + ntile * 256;
    {
        pg8::Gemm g{P + (size_t)row_lo * INW + C_RV, INW, c.WBR, DM, -1, nullptr}; pg8::StaticOrder S; S.init(ntile, 8, G, cb);
        EpiMerge<0> E{P, tile_lo};
        pg8::gemm_phase<EpiMerge<0>, pg8::StaticOrder, true, true>(lds, g, S, E);
    }
    {
        pg8::Gemm g{P + (size_t)row_lo * INW + C_AQ, INW, c.WBA, 1024, -1, nullptr}; pg8::StaticOrder S; S.init(ntile, 8, G, cb);
        EpiMerge<1> E{P, tile_lo};
        pg8::gemm_phase<EpiMerge<1>, pg8::StaticOrder, true, true>(lds, g, S, E);
    }
    PM_SYNC();
    {
        pg8::Gemm g{P + (size_t)row_lo * INW + C_GR, INW, c.WOUT, DM, -1, nullptr}; pg8::StaticOrder S; S.init(ntile, 8, G, cb);
        EpiSsq<false> E{P, 0, c.SSQ, tile_lo};
        pg8::gemm_phase<EpiSsq<false>, pg8::StaticOrder, true, true>(lds, g, S, E);
    }
    PM_SYNC();
    { PM_TID(); for (int r = row_lo + gw; r < row_hi; r += NGW) {
        const float* xr = r < MP ? c.x_p + (size_t)r * DM : c.x_s + (size_t)(r - MP) * DM;
        const float* md = c.MOD + (size_t)mod_row(r) * MODW;
        const bf16_t* zr = P + (size_t)r * INW;
        const float q = lane < 32 ? c.SSQ[(size_t)r * 32 + lane] : 0.f;
        const float rstd1 = rsqrtf(wave_sum(q) * (1.f / DM) + EPS);
        f32x4 v[8]; float s = 0.f;
#pragma unroll
        for (int j = 0; j < 8; ++j) {
            const int cc = 4 * lane + 256 * j;
            const u32x2 zb = *(const u32x2*)(zr + cc);
            const f32x4 z = (f32x4){__uint_as_float(zb.x << 16), __uint_as_float(zb.x & 0xffff0000u), __uint_as_float(zb.y << 16), __uint_as_float(zb.y & 0xffff0000u)};
            const f32x4 xx = *(const f32x4*)(xr + cc), gp = *(const f32x4*)(c.g_post1 + cc), gt = *(const f32x4*)(md + MOD_GT1 + cc);
            v[j] = xx + gt * (z * rstd1 * gp);
            *(f32x4*)(c.Y + (size_t)r * DM + cc) = v[j];
            s += (v[j].x * v[j].x + v[j].y * v[j].y) + (v[j].z * v[j].z + v[j].w * v[j].w);
        }
        const float rstd2 = rsqrtf(wave_sum(s) * (1.f / DM) + EPS);
        bf16_t* orow = P + (size_t)r * INW + C_U2;
#pragma unroll
        for (int j = 0; j < 8; ++j) {
            const int cc = 4 * lane + 256 * j;
            const f32x4 gg = *(const f32x4*)(c.g_pre2 + cc), sc = *(const f32x4*)(md + MOD_SC2 + cc), sh = *(const f32x4*)(md + MOD_SH2 + cc);
            const f32x4 o = (v[j] * rstd2) * gg * (sc + 1.f) + sh;
            u32x2 w; w.x = pk2(o.x, o.y); w.y = pk2(o.z, o.w); *(u32x2*)(orow + cc) = w;
        }
    } }
    PM_SYNC();
    const int nparts = ntile >= 2 ? 2 : 1, ptiles = ntile / nparts;
    for (int hfi = 0; hfi < nparts * REP_FFN; ++hfi) {
        const int hf = hfi % nparts;
        const int pm0 = tile_lo + hf * ptiles, nM = ptiles, prow_lo = pm0 * 256;
        {
            pg8::Gemm g{P + (size_t)prow_lo * INW + C_U2, INW, c.WUP, DM, -1, nullptr}; pg8::StaticOrder S; S.init(nM, UPW / 256, G, cb);
            EpiUp E{P, c.out, pm0};
            pg8::gemm_phase<EpiUp, pg8::StaticOrder, true, true>(lds, g, S, E);
        }
        PM_SYNC();
        {   PM_TID();
            const int nitems = (nM * 16) * 11;
            for (int it = gw; it < nitems; it += NGW) {
                const int rg = it / 11, ch = it % 11, r0 = prow_lo + rg * 16, c0 = ch * 512 + lane * 8;
                float wv_[3][8], wg_[3][8], bv_[8], bg_[8];
#pragma unroll
                for (int t = 0; t < 3; ++t)
#pragma unroll
                    for (int e = 0; e < 8; ++e) { wv_[t][e] = c.conv_w[(size_t)t * UPW + c0 + e]; wg_[t][e] = c.conv_w[(size_t)t * UPW + DFF + c0 + e]; }
#pragma unroll
                for (int e = 0; e < 8; ++e) { bv_[e] = c.conv_b[c0 + e]; bg_[e] = c.conv_b[DFF + c0 + e]; }
                float pv[2][8], pg[2][8];
                const bool smp = r0 >= MP;
                const int tfirst = smp ? 0 : (r0 & 4095);
#pragma unroll
                for (int k = 0; k < 2; ++k) {
                    if (smp) { const float* sp = c.state_conv + ((size_t)((r0 - MP) >> 4) * 2 + k) * UPW + c0;
#pragma unroll
                        for (int e = 0; e < 8; ++e) { pv[k][e] = sp[e]; pg[k][e] = sp[DFF + e]; } }
                    else if (tfirst == 0) {
#pragma unroll
                        for (int e = 0; e < 8; ++e) { pv[k][e] = 0.f; pg[k][e] = 0.f; } }
                    else { const bf16_t* up = P + (size_t)(r0 - 2 + k) * INW + C_UP + c0; const u32x4 a4 = *(const u32x4*)up, b4 = *(const u32x4*)(up + DFF);
#pragma unroll
                        for (int q = 0; q < 4; ++q) { pv[k][2 * q] = __uint_as_float(a4[q] << 16); pv[k][2 * q + 1] = __uint_as_float(a4[q] & 0xffff0000u); pg[k][2 * q] = __uint_as_float(b4[q] << 16); pg[k][2 * q + 1] = __uint_as_float(b4[q] & 0xffff0000u); } }
                }
                bf16_t* hp = h_row(c, r0) + c0;
                u32x4 na[4], nb[4];
#pragma unroll
                for (int q = 0; q < 4; ++q) { const bf16_t* up = P + (size_t)(r0 + q) * INW + C_UP + c0; na[q] = *(const u32x4*)up; nb[q] = *(const u32x4*)(up + DFF); }
#pragma unroll
                for (int tb = 0; tb < 4; ++tb) {
                    u32x4 ca[4], cbv[4];
#pragma unroll
                    for (int q = 0; q < 4; ++q) { ca[q] = na[q]; cbv[q] = nb[q]; }
                    if (tb < 3) {
#pragma unroll
                        for (int q = 0; q < 4; ++q) { const bf16_t* up = P + (size_t)(r0 + 4 * tb + 4 + q) * INW + C_UP + c0; na[q] = *(const u32x4*)up; nb[q] = *(const u32x4*)(up + DFF); }
                    }
#pragma unroll
                    for (int q = 0; q < 4; ++q) {
                        const u32x4 a4 = ca[q], b4 = cbv[q];
                        float cv_[8], cg_[8], hv[8];
#pragma unroll
                        for (int qq = 0; qq < 4; ++qq) { cv_[2 * qq] = __uint_as_float(a4[qq] << 16); cv_[2 * qq + 1] = __uint_as_float(a4[qq] & 0xffff0000u); cg_[2 * qq] = __uint_as_float(b4[qq] << 16); cg_[2 * qq + 1] = __uint_as_float(b4[qq] & 0xffff0000u); }
#pragma unroll
                        for (int e = 0; e < 8; ++e) {
                            const float val = bv_[e] + wv_[2][e] * cv_[e] + wv_[1][e] * pv[1][e] + wv_[0][e] * pv[0][e];
                            const float gt = bg_[e] + wg_[2][e] * cg_[e] + wg_[1][e] * pg[1][e] + wg_[0][e] * pg[0][e];
                            const float gl = gt * __builtin_amdgcn_rcpf(1.f + __expf(-1.5957691216057308f * (gt + 0.044715f * gt * gt * gt)));
                            hv[e] = gl * val;
                            pv[0][e] = pv[1][e]; pv[1][e] = cv_[e]; pg[0][e] = pg[1][e]; pg[1][e] = cg_[e];
                        }
                        u32x4 w; w.x = pk2(hv[0], hv[1]); w.y = pk2(hv[2], hv[3]); w.z = pk2(hv[4], hv[5]); w.w = pk2(hv[6], hv[7]);
                        *(u32x4*)(hp + (size_t)(4 * tb + q) * INW) = w;
                    }
                }
            }
        }
#ifndef CHAIN_DOWN
#define CHAIN_DOWN 1
#endif
        if (SUB && !CHAIN_DOWN) return;
        PM_SYNC();
        if constexpr (SUB) {
            constexpr int KS = 4, KSL = DFF / KS;
            pg8::Gemm g{c.HS, INW, c.WDN, KSL, -1, nullptr, DFF, (size_t)KSL * 2, (size_t)KSL * 2}; pg8::StaticOrder S; S.init(KS, 8, G, cb);
            EpiPart E{c.PART};
            pg8::gemm_phase<EpiPart, pg8::StaticOrder, true, true>(lds, g, S, E);
            PM_SYNC();
            { PM_TID(); for (int r = row_lo + gw; r < row_hi; r += NGW) {
                const float* md = c.MOD + (size_t)mod_row(r) * MODW;
                f32x4 f[8]; float s = 0.f;
#pragma unroll
                for (int j = 0; j < 8; ++j) {
                    const int cc = 4 * lane + 256 * j;
                    const float* pp = c.PART + (size_t)(r - row_lo) * DM + cc;
                    f[j] = (*(const f32x4*)pp + *(const f32x4*)(pp + (size_t)256 * DM)) + (*(const f32x4*)(pp + (size_t)512 * DM) + *(const f32x4*)(pp + (size_t)768 * DM));
                    s += (f[j].x * f[j].x + f[j].y * f[j].y) + (f[j].z * f[j].z + f[j].w * f[j].w);
                }
                const float rstd = rsqrtf(wave_sum(s) * (1.f / DM) + EPS);
#pragma unroll
                for (int j = 0; j < 8; ++j) {
                    const int cc = 4 * lane + 256 * j;
                    const f32x4 x1 = *(const f32x4*)(c.Y + (size_t)r * DM + cc), gp = *(const f32x4*)(c.g_post2 + cc), gt = *(const f32x4*)(md + MOD_GT2 + cc);
                    *(f32x4*)(c.Y + (size_t)r * DM + cc) = x1 + gt * (f[j] * rstd * gp);
                }
            } }
            return;
        }
        {
            const bool last = !CHAIN_DOWN && !SUB && hf == nparts - 1;
            pg8::Gemm g{h_row(c, prow_lo), INW, c.WDN, DFF, last ? nM : -1, c.HS}; pg8::StaticOrder S; S.init(last ? nM + 1 : nM, 8, G, cb);
            EpiSsq<false> E{P, C_F, c.SSQ, pm0};
            pg8::gemm_phase<EpiSsq<false>, pg8::StaticOrder, true, true>(lds, g, S, E);
        }
        PM_SYNC();
    }
    { PM_TID(); for (int r = row_lo + gw; r < (CHAIN_DOWN ? row_hi : MTOT); r += NGW) {
        const float* md = c.MOD + (size_t)mod_row(r) * MODW;
        const bf16_t* fr = P + (size_t)r * INW + C_F;
        const float q = lane < 32 ? c.SSQ[(size_t)r * 32 + lane] : 0.f;
        const float rstd = rsqrtf(wave_sum(q) * (1.f / DM) + EPS);
#pragma unroll
        for (int j = 0; j < 8; ++j) {
            const int cc = 4 * lane + 256 * j;
            const u32x2 fb = *(const u32x2*)(fr + cc);
            const f32x4 f = (f32x4){__uint_as_float(fb.x << 16), __uint_as_float(fb.x & 0xffff0000u), __uint_as_float(fb.y << 16), __uint_as_float(fb.y & 0xffff0000u)};
            const f32x4 x1 = *(const f32x4*)(c.Y + (size_t)r * DM + cc), gp = *(const f32x4*)(c.g_post2 + cc), gt = *(const f32x4*)(md + MOD_GT2 + cc);
            *(f32x4*)(c.Y + (size_t)r * DM + cc) = x1 + gt * (f * rstd * gp);
        }
    } }
#undef PM_SYNC
#undef PM_TID
}

__global__ void __launch_bounds__(512, 2) fwd_kernel(Args a) {
    extern __shared__ __attribute__((aligned(16))) unsigned char lds_raw[];
    LAS unsigned char* lds = (LAS unsigned char*)lds_raw;
    cg::grid_group grid = cg::this_grid();
    volatile LAS unsigned* bst = (volatile LAS unsigned*)(lds + LDS_BYTES - 64);
    if (threadIdx.x < 2) bst[threadIdx.x] = 0u;
    __syncthreads();
    const XcdBarrier xbar = xcd_barrier_post((unsigned*)(a.ws + WS_CTL) + 1024, bst);
    if (threadIdx.x == 0) bst[2] = atomicAdd((unsigned*)(a.ws + WS_CTL) + 256 + 16 * xbar.x, 1u);
#define GSYNC() xcd_barrier(xbar)
    const int G = gridDim.x, bid = blockIdx.x, NGW = G * 8;
#define PHASE_TID() int tid = threadIdx.x; asm volatile("" : "+v"(tid)); const int lane = tid & 63, wv = __builtin_amdgcn_readfirstlane(tid >> 6), gw = bid * 8 + wv; (void)lane; (void)gw
    const float *x_p = a.in[0], *x_s = a.in[1], *cache_k = a.in[2], *cache_v = a.in[3], *state_ret = a.in[4], *state_conv = a.in[5], *c_p = a.in[6], *c_s = a.in[7],
                *w_ada = a.in[8], *b_ada = a.in[9], *g_pre1 = a.in[10], *w_in = a.in[11], *rel_bias = a.in[12], *w_br_ret = a.in[13], *w_br_att = a.in[14], *w_out = a.in[15],
                *g_post1 = a.in[16], *g_pre2 = a.in[17], *w_up = a.in[18], *conv_w = a.in[19], *conv_b = a.in[20], *w_down = a.in[21], *g_post2 = a.in[22];
    float* out = a.out; unsigned char* ws = a.ws;
    unsigned* ctl = (unsigned*)(ws + WS_CTL);
    bf16_t *WIN = (bf16_t*)(ws + WS_WIN), *WUP = (bf16_t*)(ws + WS_WUP), *WDN = (bf16_t*)(ws + WS_WDN), *WBR = (bf16_t*)(ws + WS_WBR), *WBA = (bf16_t*)(ws + WS_WBA), *WOUT = (bf16_t*)(ws + WS_WOUT);
    float *MODP = (float*)(ws + WS_MODP), *MOD = (float*)(ws + WS_MOD), *SSQ = (float*)(ws + WS_SSQ);
    bf16_t *HS = (bf16_t*)(ws + WS_HS), *P = (bf16_t*)(ws + WS_PROJ);
    bf16_t* U = (bf16_t*)out;
    float* Y = out + OFF_Y;
    Ctx cx; cx.P = P; cx.HS = HS; cx.WBR = WBR; cx.WBA = WBA; cx.WOUT = WOUT; cx.WUP = WUP; cx.WDN = WDN; cx.out = out; cx.Y = Y; cx.SSQ = SSQ; cx.MOD = MOD;
    cx.x_p = x_p; cx.x_s = x_s; cx.g_post1 = g_post1; cx.g_pre2 = g_pre2; cx.g_post2 = g_post2; cx.conv_w = conv_w; cx.conv_b = conv_b; cx.state_conv = state_conv;
    cx.subbar = ctl + 64; cx.lds = lds; cx.xbar = xbar; cx.PART = MODP;

    if (PH(0)) {
        PHASE_TID();
        LAS float* scr = (LAS float*)(lds + wv * TR_BYTES);
        constexpr int I_IN = 64 * (INW / 128), I_UP = 64 * (UPW / 128), I_DN = (DFF / 32) * 16, I_BR = 64 * 16, I_BA = 32 * 16, I_OUT = 64 * 16, I_MOD = 16 * 48;
        constexpr int NIT = I_IN + I_UP + I_DN + I_BR + I_BA + I_OUT + I_MOD;
        for (int it = gw; it < NIT; it += NGW) {
            int r = it;
            if (r < I_MOD) { mod_item(c_p, c_s, w_ada, MODP, scr, r, lane); continue; } r -= I_MOD;
            if (r < I_IN) { transpose_item(w_in, DM, INW, WIN, scr, r, lane, true); continue; } r -= I_IN;
            if (r < I_UP) { transpose_item(w_up, DM, UPW, WUP, scr, r, lane, false); continue; } r -= I_UP;
            if (r < I_DN) { transpose_item(w_down, DFF, DM, WDN, scr, r, lane, false); continue; } r -= I_DN;
            if (r < I_BR) { transpose_item(w_br_ret, DM, DM, WBR, scr, r, lane, false); continue; } r -= I_BR;
            if (r < I_BA) { transpose_item(w_br_att, 1024, DM, WBA, scr, r, lane, false); continue; } r -= I_BA;
            transpose_item(w_out, DM, DM, WOUT, scr, r, lane, false);
        }
    }
    grid.sync();
    {
        if (threadIdx.x == 0) {
            const unsigned* xc = (const unsigned*)(a.ws + WS_CTL) + 256; const unsigned rk = bst[2]; unsigned v = 0;
            for (unsigned j = 0; j < 16; ++j) { const unsigned n = __hip_atomic_load(xc + 16 * j, __ATOMIC_RELAXED, __HIP_MEMORY_SCOPE_AGENT); v += n < rk ? n : rk; if (j < xbar.x && n > rk) ++v; }
            bst[3] = v;
        }
        __syncthreads();
    }
    const int vbid = (int)bst[3];
    if (PH(1)) { PHASE_TID(); for (int i = bid * 512 + tid; i < 24 * MODW / 4; i += G * 512) {
        const int r = i / (MODW / 4), c4 = (i % (MODW / 4)) * 4;
        f32x4 s = *(const f32x4*)(b_ada + c4);
#pragma unroll
        for (int sl = 0; sl < 16; ++sl) s += *(const f32x4*)(MODP + ((size_t)sl * 24 + r) * MODW + c4);
        *(f32x4*)(MOD + (size_t)r * MODW + c4) = s;
    } }
    GSYNC();
    if (PH(2)) { PHASE_TID(); for (int r = gw; r < MTOT; r += NGW) {
        const float* xr = r < MP ? x_p + (size_t)r * DM : x_s + (size_t)(r - MP) * DM;
        const float* md = MOD + (size_t)mod_row(r) * MODW;
        norm_mod_row(xr, g_pre1, md + MOD_SC1, md + MOD_SH1, U + (size_t)r * DM, lane);
    } }
    GSYNC();
    for (int rep1 = 0; rep1 < REP_P1; ++rep1) if (PH(3)) {
        pg8::Gemm g{U, DM, WIN, DM, -1, nullptr}; pg8::StaticOrder S; S.init(NTILE, INW / 256, G, vbid);
        EpiProj E{P, out};
        pg8::gemm_phase<EpiProj, pg8::StaticOrder, true, true>(lds, g, S, E);
    }
    GSYNC();
#ifdef DRY_P2
    {   PHASE_TID();
        LAS float* bl = (LAS float*)lds;
        for (int i = tid; i < 8 * 257; i += 512) bl[i] = rel_bias[i];
        __syncthreads();
        if (bid < 64) {
            ret_prompt_unit<true>(P, out, bid >> 3, bid & 7, lds, tid);
            __syncthreads();
            for (int i = tid; i < 8 * 257; i += 512) bl[i] = rel_bias[i];
            __syncthreads();
        }
        int tid_b = threadIdx.x; asm volatile("" : "+v"(tid_b)); const int lane_b = tid_b & 63;
        for (;;) {
            unsigned u = 0; if (lane_b == 0) u = atomicAdd(ctl + 1, 1u);
            u = (unsigned)__builtin_amdgcn_readfirstlane((int)u);
            if (u >= 8192u) break;
            att_unit<true>(P, (LAS float*)lds, (int)u, lane_b);
        }
    }
    GSYNC();
#endif
#ifdef DRY_ATT
    {   PHASE_TID();
        LAS float* bl = (LAS float*)lds;
        for (int i = tid; i < 8 * 257; i += 512) bl[i] = rel_bias[i];
        __syncthreads();
        for (;;) {
            unsigned u = 0; if (lane == 0) u = atomicAdd(ctl + 1, 1u);
            u = (unsigned)__builtin_amdgcn_readfirstlane((int)u);
            if (u >= 8192u) break;
            att_unit<true>(P, bl, (int)u, lane);
        }
    }
    GSYNC();
#endif
#ifdef DRY_RET
    {   PHASE_TID();
        if (bid < 64) ret_prompt_unit<true>(P, out, bid >> 3, bid & 7, lds, tid);
    }
    GSYNC();
#endif
    if (PH(4)) {
        PHASE_TID();
        LAS float* bl = (LAS float*)lds;
        for (int i = tid; i < 8 * 257; i += 512) bl[i] = rel_bias[i];
        __syncthreads();
        LAS unsigned char* scr = lds + 8448;
        constexpr int NSB = 44;
        {
            for (int u = bid; u < 256; u += G) {
                if (u < 128) { if (P2SUB & 2) ret_sample_unit(P, state_ret, out, u >> 3, u & 7, scr, tid); }
                else { if (P2SUB & 4) att_sample_unit(P, cache_k, cache_v, rel_bias, (u - 128) >> 3, (u - 128) & 7, scr, tid); }
            }
            asm volatile("s_waitcnt vmcnt(0)" ::: "memory");
            __syncthreads();
            if (tid == 0) { __builtin_amdgcn_fence(__ATOMIC_RELEASE, "agent"); asm volatile("s_waitcnt vmcnt(0)" ::: "memory"); (void)__hip_atomic_fetch_add(ctl + 128, 1u, __ATOMIC_RELAXED, __HIP_MEMORY_SCOPE_AGENT); }
        }
        if (bid < 64) { if (P2SUB & 1) ret_prompt_unit<false>(P, out, bid >> 3, bid & 7, lds, tid); }
        else {
            if (bid < 64 + NSB) {
                if (tid == 0) { unsigned sp = 0; while (__hip_atomic_load(ctl + 128, __ATOMIC_RELAXED, __HIP_MEMORY_SCOPE_AGENT) < (unsigned)G) { __builtin_amdgcn_s_sleep(2); if (++sp > (1u << 22)) break; }
                    __builtin_amdgcn_fence(__ATOMIC_ACQUIRE, "agent"); asm volatile("s_waitcnt vmcnt(0)" ::: "memory"); }
                __syncthreads();
                unsigned sg = 0;
                post_mixer<true>(cx, 128, 1, NSB, bid - 64, sg);
                __syncthreads();
                for (int i = tid; i < 8 * 257; i += 512) bl[i] = rel_bias[i];
                __syncthreads();
            }
        }
        int tid_b = threadIdx.x; asm volatile("" : "+v"(tid_b)); const int lane_b = tid_b & 63;
        for (unsigned kq = 0; kq < 8; ++kq) {
            const unsigned q = (xbar.x + kq) & 7u;
            for (;;) {
                unsigned u = 0; if (lane_b == 0) u = atomicAdd(ctl + 512 + 16 * q, 1u);
                u = (unsigned)__builtin_amdgcn_readfirstlane((int)u);
                if (u >= 1024u) break;
                if (P2SUB & 8) att_unit<false>(P, (LAS float*)lds, (int)(q * 1024u + u), lane_b);
            }
        }
    }
    GSYNC();
    {
        unsigned sg = 0;
        post_mixer<false>(cx, 0, 128, G, vbid, sg);
    }
}

extern "C" void kernel_launch(void* const* d_in, const int* in_sizes, int n_in, void* d_out, int out_size, void* d_ws, size_t ws_size, hipStream_t stream) {
    static int grid = 0;
    if (grid == 0) {
        if (n_in != 23 || ws_size < WS_END) { fprintf(stderr, "kernel_launch: unexpected inputs (n_in %d, ws %zu, need %zu)\n", n_in, ws_size, (size_t)WS_END); grid = -1; return; }
        int dev = 0, cus = 0, per_cu = 0;
        (void)hipGetDevice(&dev); (void)hipDeviceGetAttribute(&cus, hipDeviceAttributeMultiprocessorCount, dev);
        if (hipFuncSetAttribute((const void*)fwd_kernel, hipFuncAttributeMaxDynamicSharedMemorySize, LDS_BYTES) != hipSuccess) { fprintf(stderr, "kernel_launch: hipFuncSetAttribute failed\n"); grid = -1; return; }
        if (hipOccupancyMaxActiveBlocksPerMultiprocessor(&per_cu, (const void*)fwd_kernel, 512, LDS_BYTES) != hipSuccess || per_cu < 1) per_cu = 1;
        (void)hipGetLastError();
        grid = cus * 1;
        if (grid <= 0) grid = 256;
    }
    if (grid < 0) return;
    (void)hipMemsetAsync((char*)d_ws + WS_CTL, 0, 65536, stream);
    Args a{};
    for (int i = 0; i < 23; ++i) a.in[i] = (const float*)d_in[i];
    a.out = (float*)d_out; a.ws = (unsigned char*)d_ws;
    void* args[] = {&a};
    hipError_t e = hipLaunchCooperativeKernel((const void*)fwd_kernel, dim3(grid), dim3(512), args, LDS_BYTES, stream);
    if (e != hipSuccess) fprintf(stderr, "kernel_launch: cooperative launch failed: %s (grid %d)\n", hipGetErrorString(e), grid);
}
```

```cpp
#include <hip/hip_runtime.h>
#include <hip/hip_cooperative_groups.h>
#include <cstdio>
#include <cstdint>
namespace cg = cooperative_groups;
#define DI __device__ __forceinline__
namespace pg8 {
#define PG8_LAS __attribute__((address_space(3)))
typedef unsigned short bf16_t;
typedef short bf16x8 __attribute__((ext_vector_type(8)));
typedef float f32x4 __attribute__((ext_vector_type(4)));
typedef unsigned u32x4 __attribute__((ext_vector_type(4)));
typedef unsigned u32x2 __attribute__((ext_vector_type(2)));
constexpr int BM = 256, BK = 64, HALF = 128, HTB = HALF * BK * 2, STAGE_BYTES = 8 * HTB, NXCD = 8, WGM = 8;
__host__ __device__ __forceinline__ int lds_byte(int r, int c) { const int st = (r >> 4) * 2 + (c >> 5), rr = r & 15, cc = c & 31, ob = rr * 64 + cc * 2; return st * 1024 + (ob ^ (((ob >> 9) & 1) << 5)); }
__host__ __device__ __forceinline__ void stage_rc(int b, int& R, int& C) { const int st = b / 1024, sb = b % 1024, swz = sb ^ (((sb >> 9) & 1) << 5); R = (st >> 1) * 16 + swz / 64; C = (st & 1) * 32 + (swz % 64) / 2; }
__host__ __device__ __forceinline__ int perm32(int rho) { const int n = rho >> 4, i = rho & 15; return 8 * (i >> 2) + 4 * n + (i & 3); }
struct Unit { int pm, pn; };
struct Gemm { const bf16_t* A; int lda; const bf16_t* Bt; int K; int spm; const bf16_t* As; int ldb = 0; size_t a_tile_bytes = 0, b_pm_bytes = 0; };
__device__ __forceinline__ const char* tileA(const Gemm& g, int pm, size_t tstepA) { return pm == g.spm ? (const char*)g.As : (const char*)g.A + (size_t)pm * (g.a_tile_bytes ? g.a_tile_bytes : tstepA); }
struct StaticOrder {
    int nM, nN, nwg, G, c;
    __host__ __device__ void init(int nM_, int nN_, int G_, int c_) { nM = nM_; nN = nN_; nwg = nM * nN; G = G_; c = c_; }
    __host__ __device__ bool next(int i, Unit& u) const {
        const long L = (long)i * G + c; if (L >= nwg) return false;
        int wgid = (int)L; { const int q = nwg / NXCD, r = nwg % NXCD, xcd = wgid % NXCD, off = wgid / NXCD; wgid = (xcd < r ? xcd * (q + 1) : r * (q + 1) + (xcd - r) * q) + off; }
        const int nig = WGM * nN, gid = wgid / nig, fm = gid * WGM, gsz = (nM - fm) < WGM ? (nM - fm) : WGM;
        u.pm = fm + ((wgid % nig) % gsz); u.pn = (wgid % nig) / gsz; return true;
    }
    __device__ __forceinline__ void a_ready(const Unit&) const {}
    __device__ __forceinline__ void done(const Unit&) const {}
};
__device__ __forceinline__ unsigned cvt_pk_bf16(float lo, float hi) { unsigned r; asm volatile("v_cvt_pk_bf16_f32 %0, %1, %2" : "=v"(r) : "v"(lo), "v"(hi)); return r; }
template <class Epi, class Sched, bool ALIGN_EPI = false, bool SP2 = false>
__device__ __forceinline__ void gemm_phase(PG8_LAS unsigned char* lds, const Gemm g, const Sched& S, const Epi& E) {
    int tid_ = threadIdx.x; asm volatile("" : "+v"(tid_));
    const int tid = tid_, wid = __builtin_amdgcn_readfirstlane(tid >> 6), lane = tid & 63, wr = wid >> 2, wc = wid & 3, fr = lane & 15, fq = lane >> 4;
    const int K = g.K, nt = K / BK;
    unsigned voffA[2], voffB[2];
#pragma unroll
    for (int i = 0; i < 2; ++i) { int R, C; stage_rc(tid * 16 + i * 8192, R, C); const int Rb = Epi::PERM ? ((R & ~31) + perm32(R & 31)) : R;
        voffA[i] = (unsigned)(R * g.lda + C) * 2u; voffB[i] = (unsigned)(Rb * (g.ldb ? g.ldb : K) + C) * 2u; }
    const size_t kstep = (size_t)(BK * 2);
    const size_t hstepA = (size_t)HALF * g.lda * 2, hstepB = (size_t)HALF * (g.ldb ? g.ldb : K) * 2;
    const size_t tstepA = 2 * hstepA, tstepB = 2 * hstepB;
    const unsigned ldsw = (unsigned)wid * 1024u;
    const int aoff = lds_byte(wr * 64 + fr, fq * 8), boff = lds_byte(wc * 32 + fr, fq * 8);
#define PG8_SA(b, h) (((b) * 2 + (h)) * HTB)
#define PG8_SB(b, h) ((4 + (b) * 2 + (h)) * HTB)
#define PG8_STAGE(bufoff, gbase, voff) do { _Pragma("unroll") for (int _i = 0; _i < 2; ++_i) \
        __builtin_amdgcn_global_load_lds((const unsigned*)((const char*)(gbase) + (voff)[_i]), (PG8_LAS unsigned*)(lds + (bufoff) + ldsw + _i * 8192), 16, 0, 0); } while (0)
#define PG8_LDA(dst, b, h) do { _Pragma("unroll") for (int m = 0; m < 4; ++m) _Pragma("unroll") for (int k = 0; k < 2; ++k) dst[m][k] = *(const PG8_LAS bf16x8*)(lds + PG8_SA(b, h) + aoff + m * 2048 + k * 1024); } while (0)
#define PG8_LDB(dst, b, h) do { _Pragma("unroll") for (int n = 0; n < 2; ++n) _Pragma("unroll") for (int k = 0; k < 2; ++k) dst[n][k] = *(const PG8_LAS bf16x8*)(lds + PG8_SB(b, h) + boff + n * 2048 + k * 1024); } while (0)
#define PG8_MMA(ai, bj, At, Bt) do { __builtin_amdgcn_s_setprio(1); _Pragma("unroll") for (int m = 0; m < 4; ++m) _Pragma("unroll") for (int n = 0; n < 2; ++n) _Pragma("unroll") for (int k = 0; k < 2; ++k) \
        acc[ai][bj][m][n] = __builtin_amdgcn_mfma_f32_16x16x32_bf16(Bt[n][k], At[m][k], acc[ai][bj][m][n], 0, 0, 0); __builtin_amdgcn_s_setprio(0); } while (0)
#define PG8_WAIT_V(n) asm volatile("s_waitcnt vmcnt(" #n ")" ::: "memory")
#define PG8_WAIT_L(n) asm volatile("s_waitcnt lgkmcnt(" #n ")" ::: "memory")
#define PG8_BAR __builtin_amdgcn_s_barrier()
#define PG8_SCHED __builtin_amdgcn_sched_barrier(0)
    Unit cur, nxt; int ui = 0;
    if (!S.next(0, cur)) return;
    f32x4 acc[2][2][4][2];
#pragma unroll
    for (int a = 0; a < 2; ++a)
#pragma unroll
        for (int b = 0; b < 2; ++b)
#pragma unroll
            for (int m = 0; m < 4; ++m)
#pragma unroll
                for (int n = 0; n < 2; ++n) acc[a][b][m][n] = (f32x4){0.f, 0.f, 0.f, 0.f};
    bf16x8 At[4][2], B0[2][2], B1[2][2];
    const char* cA = tileA(g, cur.pm, tstepA); const char* cB = (const char*)g.Bt + (size_t)cur.pn * tstepB + (size_t)cur.pm * g.b_pm_bytes;
    S.a_ready(cur);
    if constexpr (SP2) {
        PG8_STAGE(PG8_SB(0, 0), cB, voffB); PG8_STAGE(PG8_SB(0, 1), cB + hstepB, voffB); PG8_STAGE(PG8_SA(0, 0), cA, voffA); PG8_STAGE(PG8_SA(0, 1), cA + hstepA, voffA);
        if (wr == 1) PG8_BAR;
        PG8_WAIT_V(2); PG8_BAR;
        PG8_STAGE(PG8_SB(1, 0), cB + kstep, voffB); PG8_STAGE(PG8_SA(1, 0), cA + kstep, voffA); PG8_STAGE(PG8_SB(1, 1), cB + hstepB + kstep, voffB);
        PG8_WAIT_V(6); PG8_BAR;
    } else {
        PG8_STAGE(PG8_SB(0, 0), cB, voffB); PG8_STAGE(PG8_SA(0, 0), cA, voffA); PG8_STAGE(PG8_SB(0, 1), cB + hstepB, voffB); PG8_STAGE(PG8_SA(0, 1), cA + hstepA, voffA);
        if (wr == 1) PG8_BAR;
        PG8_WAIT_V(4); PG8_BAR;
        PG8_STAGE(PG8_SB(1, 0), cB + kstep, voffB); PG8_STAGE(PG8_SA(1, 0), cA + kstep, voffA); PG8_STAGE(PG8_SB(1, 1), cB + hstepB + kstep, voffB);
        PG8_WAIT_V(6); PG8_BAR;
    }
    for (;;) {
        const bool has_next = S.next(ui + 1, nxt);
        const char* nA = has_next ? tileA(g, nxt.pm, tstepA) : cA; const char* nB = has_next ? (const char*)g.Bt + (size_t)nxt.pn * tstepB + (size_t)nxt.pm * g.b_pm_bytes : cB;
        for (int t = 0; t < nt; t += 2) {
            const bool last = (t == nt - 2);
            const char* a1 = cA + (size_t)(t + 1) * kstep;
            const char* a2 = last ? nA : cA + (size_t)(t + 2) * kstep; const char* b2 = last ? nB : cB + (size_t)(t + 2) * kstep;
            const char* a3 = a2 + kstep; const char* b3 = b2 + kstep;
            if (last && has_next) S.a_ready(nxt);
            if constexpr (SP2) {
            PG8_LDB(B0, 0, 0); PG8_LDB(B1, 0, 1); PG8_SCHED; PG8_LDA(At, 0, 0); PG8_STAGE(PG8_SA(1, 1), a1 + hstepA, voffA);
            PG8_WAIT_V(8); PG8_WAIT_L(0); PG8_BAR; PG8_MMA(0, 0, At, B0); PG8_MMA(0, 1, At, B1); PG8_BAR; PG8_SCHED;
            PG8_LDA(At, 0, 1); PG8_STAGE(PG8_SB(0, 0), b2, voffB); PG8_STAGE(PG8_SB(0, 1), b2 + hstepB, voffB); PG8_STAGE(PG8_SA(0, 0), a2, voffA);
            PG8_WAIT_V(8); PG8_WAIT_L(0); PG8_BAR; PG8_MMA(1, 0, At, B0); PG8_MMA(1, 1, At, B1); PG8_BAR; PG8_SCHED;
            PG8_LDB(B0, 1, 0); PG8_LDB(B1, 1, 1); PG8_SCHED; PG8_LDA(At, 1, 0); PG8_STAGE(PG8_SA(0, 1), a2 + hstepA, voffA);
            PG8_WAIT_V(8); PG8_WAIT_L(0); PG8_BAR; PG8_MMA(0, 0, At, B0); PG8_MMA(0, 1, At, B1); PG8_BAR; PG8_SCHED;
            PG8_LDA(At, 1, 1); PG8_STAGE(PG8_SB(1, 0), b3, voffB); PG8_STAGE(PG8_SB(1, 1), b3 + hstepB, voffB); PG8_STAGE(PG8_SA(1, 0), a3, voffA);
            PG8_WAIT_V(8); PG8_WAIT_L(0); PG8_BAR; PG8_MMA(1, 0, At, B0); PG8_MMA(1, 1, At, B1); PG8_BAR; PG8_SCHED;
            } else {
            PG8_LDB(B0, 0, 0); PG8_SCHED; PG8_LDA(At, 0, 0); PG8_STAGE(PG8_SA(1, 1), a1 + hstepA, voffA);
            PG8_WAIT_L(8); PG8_BAR; PG8_WAIT_L(0); PG8_MMA(0, 0, At, B0); PG8_BAR; PG8_SCHED;
            PG8_LDB(B1, 0, 1); PG8_STAGE(PG8_SB(0, 0), b2, voffB);
            PG8_BAR; PG8_WAIT_L(0); PG8_MMA(0, 1, At, B1); PG8_BAR;
            PG8_LDA(At, 0, 1); PG8_STAGE(PG8_SA(0, 0), a2, voffA);
            PG8_BAR; PG8_WAIT_L(0); PG8_MMA(1, 0, At, B0); PG8_BAR; PG8_SCHED;
            PG8_STAGE(PG8_SB(0, 1), b2 + hstepB, voffB);
            PG8_WAIT_V(6); PG8_BAR; PG8_MMA(1, 1, At, B1); PG8_BAR;
            PG8_LDB(B0, 1, 0); PG8_SCHED; PG8_LDA(At, 1, 0); PG8_STAGE(PG8_SA(0, 1), a2 + hstepA, voffA);
            PG8_WAIT_L(8); PG8_BAR; PG8_WAIT_L(0); PG8_MMA(0, 0, At, B0); PG8_BAR; PG8_SCHED;
            PG8_LDB(B1, 1, 1); PG8_STAGE(PG8_SB(1, 0), b3, voffB);
            PG8_BAR; PG8_WAIT_L(0); PG8_MMA(0, 1, At, B1); PG8_BAR;
            PG8_LDA(At, 1, 1); PG8_STAGE(PG8_SA(1, 0), a3, voffA);
            PG8_BAR; PG8_WAIT_L(0); PG8_MMA(1, 0, At, B0); PG8_BAR; PG8_SCHED;
            PG8_STAGE(PG8_SB(1, 1), b3 + hstepB, voffB);
            PG8_WAIT_V(6); PG8_BAR; PG8_MMA(1, 1, At, B1); PG8_BAR;
            }
        }
        if constexpr (ALIGN_EPI) { if (wr == 0) PG8_BAR; }
        if constexpr (!Epi::AFTER_DRAIN) { E(acc, cur, wr, wc, fr, fq); if constexpr (Epi::TWICE) { asm volatile("" ::: "memory"); E(acc, cur, wr, wc, fr, fq); } S.done(cur); }
        if (!has_next) break;
#pragma unroll
        for (int a = 0; a < 2; ++a)
#pragma unroll
            for (int b = 0; b < 2; ++b)
#pragma unroll
                for (int m = 0; m < 4; ++m)
#pragma unroll
                    for (int n = 0; n < 2; ++n) acc[a][b][m][n] = (f32x4){0.f, 0.f, 0.f, 0.f};
        cur = nxt; cA = nA; cB = nB; ++ui;
        if constexpr (ALIGN_EPI) { if (wr == 1) PG8_BAR; }
    }
    PG8_WAIT_V(0);
    if constexpr (!ALIGN_EPI) { if (wr == 0) PG8_BAR; }
    PG8_BAR;
    if constexpr (Epi::AFTER_DRAIN) { E.fused(acc, cur, wr, wc, fr, fq, lds, wid, lane); S.done(cur); }
#undef PG8_SA
#undef PG8_SB
#undef PG8_STAGE
#undef PG8_LDA
#undef PG8_LDB
#undef PG8_MMA
#undef PG8_WAIT_V
#undef PG8_WAIT_L
#undef PG8_BAR
#undef PG8_SCHED
}
}

using pg8::bf16_t; using pg8::bf16x8; using pg8::f32x4; using pg8::u32x4; using pg8::u32x2; using pg8::Unit;
typedef float f32x16 __attribute__((ext_vector_type(16)));
#define LAS __attribute__((address_space(3)))
constexpr int DM = 2048, SEQ = 4096, NBATCH = 8, MP = NBATCH * SEQ, MS = 256, MTOT = MP + MS, NTILE = MTOT / 256;
constexpr int INW = 13312, DFF = 5632, UPW = 2 * DFF;
constexpr int C_RQ = 0, C_RK = 1024, C_RV = 2048, C_RG = 4096, C_AQ = 6144, C_AK = 7168, C_AV = 8192, C_GR = 9216, C_GA = 11264;
constexpr int C_U2 = 0, C_UP = 2048, C_H = 2048, C_F = 2048 + DFF;
constexpr float EPS = 1e-6f;
constexpr size_t OFF_Y = 0, OFF_KP = (size_t)MTOT * DM, OFF_VP = OFF_KP + 4194304, OFF_RP = OFF_VP + 4194304, OFF_CP = OFF_RP + 2097152,
                 OFF_KS = OFF_CP + 180224, OFF_VS = OFF_KS + 262144, OFF_RS = OFF_VS + 262144, OFF_CS = OFF_RS + 4194304;
constexpr size_t MiB = 1u << 20;
constexpr size_t WS_CTL = 0, WS_WIN = 1 * MiB, WS_WUP = 53 * MiB, WS_WDN = 97 * MiB, WS_WBR = 119 * MiB, WS_WBA = 127 * MiB, WS_WOUT = 131 * MiB,
                 WS_MODP = 139 * MiB, WS_MOD = 157 * MiB, WS_SSQ = 159 * MiB, WS_HS = 164 * MiB, WS_PROJ = 171 * MiB, WS_END = WS_PROJ + (size_t)MTOT * INW * 2;
static_assert(WS_END <= 1024 * MiB, "ws map");
constexpr int LDS_BYTES = 147456;
constexpr int MOD_SH1 = 0, MOD_SC1 = 2048, MOD_GT1 = 4096, MOD_SH2 = 6144, MOD_SC2 = 8192, MOD_GT2 = 10240, MODW = 12288;

DI float bf2f(unsigned short v) { return __uint_as_float((unsigned)v << 16); }
typedef __bf16 hwbf2 __attribute__((ext_vector_type(2)));
typedef float hwf2 __attribute__((ext_vector_type(2)));
DI unsigned pk2(float lo, float hi) { hwf2 v = {lo, hi}; return __builtin_bit_cast(unsigned, __builtin_convertvector(v, hwbf2)); }
DI unsigned f2bf(float f) { return pk2(f, f) & 0xffffu; }
DI float wave_sum(float v) {
#pragma unroll
    for (int o = 1; o < 64; o <<= 1) v += __shfl_xor(v, o);
    return v;
}
DI float sigmoidf_(float x) { return __builtin_amdgcn_rcpf(1.f + __expf(-x)); }
DI int crow(int reg, int h) { return (reg & 3) + 8 * (reg >> 2) + 4 * h; }
#define MFMA32(a, b, c) __builtin_amdgcn_mfma_f32_32x32x16_bf16((a), (b), (c), 0, 0, 0)
DI bf16x8 pack_step(const f32x16& x, int s) {
    u32x4 p;
    p[0] = pk2(x[8 * s + 0], x[8 * s + 1]); p[1] = pk2(x[8 * s + 2], x[8 * s + 3]); p[2] = pk2(x[8 * s + 4], x[8 * s + 5]); p[3] = pk2(x[8 * s + 6], x[8 * s + 7]);
    return __builtin_bit_cast(bf16x8, p);
}
DI int mod_row(int r) { return r < MP ? (r >> 12) : 8 + ((r - MP) >> 4); }

#ifndef PHMASK
#define PHMASK 0xffff
#endif
#define PH(k) ((PHMASK >> (k)) & 1)
#ifndef REP_P0
#define REP_P0 1
#endif
#ifndef REP_P1
#define REP_P1 1
#endif
#ifndef REP_FFN
#define REP_FFN 1
#endif
#ifndef P2SUB
#define P2SUB 15
#endif
struct Args { const float* in[23]; float* out; unsigned char* ws; };

#ifndef EPI_TWICE_PROJ
#define EPI_TWICE_PROJ false
#endif
struct EpiProj {
    static constexpr bool PERM = true, AFTER_DRAIN = false, TWICE = EPI_TWICE_PROJ;
    bf16_t* P; float* out;
    DI void operator()(const f32x4 (&acc)[2][2][4][2], const Unit& u, int wr, int wc, int fr, int fq) const {
        const int pn = u.pn, pm = u.pm;
        const int rbase = pm * 256 + wr * 64 + fr;
        if (pn < 8) {
            const float scale = pn >= 4 ? 0.08838834764831845f : 1.f;
            const int i0 = 16 * wc + 4 * fq;
            float inv[4];
#pragma unroll
            for (int e = 0; e < 4; ++e) inv[e] = exp2f(-(float)(i0 + e) * (13.287712379549449f / 64.f));
#pragma unroll
            for (int ai = 0; ai < 2; ++ai)
#pragma unroll
                for (int m = 0; m < 4; ++m) {
                    const int r = rbase + ai * 128 + m * 16;
                    const float pos = (float)(r < MP ? (r & 4095) : 4096 + (r & 15));
                    float cs[4], sn[4];
#pragma unroll
                    for (int e = 0; e < 4; ++e) { float rev = (pos * inv[e]) * 0.15915494309189535f; rev -= floorf(rev); sn[e] = __builtin_amdgcn_sinf(rev); cs[e] = __builtin_amdgcn_cosf(rev); }
                    bf16_t* rowp = P + (size_t)r * INW + pn * 256;
#pragma unroll
                    for (int bj = 0; bj < 2; ++bj) {
                        const f32x4 x1 = acc[ai][bj][m][0], x2 = acc[ai][bj][m][1];
                        float o1[4], o2[4];
#pragma unroll
                        for (int e = 0; e < 4; ++e) { o1[e] = (x1[e] * cs[e] - x2[e] * sn[e]) * scale; o2[e] = (x1[e] * sn[e] + x2[e] * cs[e]) * scale; }
                        u32x2 w1, w2; w1.x = pk2(o1[0], o1[1]); w1.y = pk2(o1[2], o1[3]); w2.x = pk2(o2[0], o2[1]); w2.y = pk2(o2[2], o2[3]);
                        *(u32x2*)(rowp + bj * 128 + i0) = w1; *(u32x2*)(rowp + bj * 128 + 64 + i0) = w2;
                    }
                }
            return;
        }
        const bool isv = (pn >= 8 && pn < 16) || (pn >= 32 && pn < 36);
        if (isv && pm < 128) {
            const int hh = (fr >> 2) & 1, j = ((fr >> 3) << 2) | (fr & 3);
#pragma unroll
            for (int ai = 0; ai < 2; ++ai)
#pragma unroll
                for (int m = 0; m < 4; ++m) {
                    const int rowblk = pm * 256 + ai * 128 + wr * 64 + m * 16;
#pragma unroll
                    for (int bj = 0; bj < 2; ++bj)
#pragma unroll
                        for (int n = 0; n < 2; ++n) {
                            bf16_t* p;
                            if (pn >= 32) { const int bb = (pn - 32) * 8 + bj * 4 + wc;
                                p = P + (size_t)(rowblk + (bb >> 1)) * INW + C_AV + (bb & 1) * 512 + (hh * 32 + 8 * fq + 4 * n) * 8 + j; }
                            else p = P + (size_t)(rowblk + hh * 8 + 2 * fq + n) * INW + pn * 256 + bj * 128 + wc * 32 + j;
                            const f32x4 v = acc[ai][bj][m][n];
#pragma unroll
                            for (int e = 0; e < 4; ++e) p[8 * e] = (bf16_t)f2bf(v[e]);
                        }
                }
        } else if (pn >= 28 && pn < 32 && pm < 128) {
            const int ks = 2 * wc + (fq >> 1), khh = fq & 1;
#pragma unroll
            for (int ai = 0; ai < 2; ++ai)
#pragma unroll
                for (int m = 0; m < 4; ++m) {
                    const int r = rbase + ai * 128 + m * 16;
#pragma unroll
                    for (int bj = 0; bj < 2; ++bj) {
                        const int blk = ((pn - 28) * 2 + bj) * 8 + ks;
                        const f32x4 v0 = acc[ai][bj][m][0], v1 = acc[ai][bj][m][1];
                        u32x4 w; w.x = pk2(v0[0], v0[1]); w.y = pk2(v0[2], v0[3]); w.z = pk2(v1[0], v1[1]); w.w = pk2(v1[2], v1[3]);
                        *(u32x4*)(P + (size_t)((r & ~31) + (blk >> 1)) * INW + C_AK + (blk & 1) * 512 + ((r & 31) + 32 * khh) * 8) = w;
                    }
                }
        } else {
            const int act = (pn >= 16 && pn < 24) ? 1 : (pn >= 36 ? 2 : 0);
            const float sc = (pn >= 24 && pn < 28) ? 0.08838834764831845f : 1.f;
#pragma unroll
            for (int ai = 0; ai < 2; ++ai)
#pragma unroll
                for (int m = 0; m < 4; ++m) {
                    bf16_t* rowp = P + (size_t)(rbase + ai * 128 + m * 16) * INW + pn * 256 + wc * 32 + 8 * fq;
#pragma unroll
                    for (int bj = 0; bj < 2; ++bj) {
                        f32x4 v0 = acc[ai][bj][m][0] * sc, v1 = acc[ai][bj][m][1] * sc;
                        if (act) {
#pragma unroll
                            for (int e = 0; e < 4; ++e) { const float s0 = sigmoidf_(v0[e]), s1 = sigmoidf_(v1[e]); v0[e] = act == 1 ? v0[e] * s0 : s0; v1[e] = act == 1 ? v1[e] * s1 : s1; }
                        }
                        u32x4 w; w.x = pk2(v0[0], v0[1]); w.y = pk2(v0[2], v0[3]); w.z = pk2(v1[0], v1[1]); w.w = pk2(v1[2], v1[3]);
                        *(u32x4*)(rowp + bj * 128) = w;
                    }
                }
        }
        const bool isk = pn >= 28 && pn < 32, isav = pn >= 32 && pn < 36;
        if ((isk || isav) && (pm == 128 || (pm & 15) >= 14)) {
            float* ob; size_t rowidx0;
            if (pm == 128) { ob = out + (isk ? OFF_KS : OFF_VS); rowidx0 = 0; }
            else { ob = out + (isk ? OFF_KP : OFF_VP); rowidx0 = (size_t)(pm >> 4) * 512 + ((pm & 15) - 14) * 256; }
            const int cseg = (pn - (isk ? 28 : 32)) * 256 + wc * 32 + 8 * fq;
#pragma unroll
            for (int ai = 0; ai < 2; ++ai)
#pragma unroll
                for (int m = 0; m < 4; ++m) {
                    float* rowp = ob + (rowidx0 + ai * 128 + wr * 64 + m * 16 + fr) * 1024 + cseg;
#pragma unroll
                    for (int bj = 0; bj < 2; ++bj) { *(f32x4*)(rowp + bj * 128) = acc[ai][bj][m][0]; *(f32x4*)(rowp + bj * 128 + 4) = acc[ai][bj][m][1]; }
                }
        }
    }
};
template <int MODE> struct EpiMerge {
    static constexpr bool PERM = true, AFTER_DRAIN = false, TWICE = false;
    bf16_t* P; int pm0;
    DI void operator()(const f32x4 (&acc)[2][2][4][2], const Unit& u, int wr, int wc, int fr, int fq) const {
        const int rbase = (u.pm + pm0) * 256 + wr * 64 + fr, cb = u.pn * 256 + wc * 32 + 8 * fq;
#pragma unroll
        for (int ai = 0; ai < 2; ++ai) {
            u32x4 tv[4][2], gv[4][2];
#pragma unroll
            for (int m = 0; m < 4; ++m) {
                const bf16_t* rowp = P + (size_t)(rbase + ai * 128 + m * 16) * INW + cb;
#pragma unroll
                for (int bj = 0; bj < 2; ++bj) { tv[m][bj] = *(const u32x4*)(rowp + C_GR + bj * 128); if (MODE == 1) gv[m][bj] = *(const u32x4*)(rowp + C_GA + bj * 128); else gv[m][bj] = tv[m][bj]; }
            }
#pragma unroll
            for (int m = 0; m < 4; ++m) {
                bf16_t* rowp = P + (size_t)(rbase + ai * 128 + m * 16) * INW + cb;
#pragma unroll
                for (int bj = 0; bj < 2; ++bj) {
                    const u32x4 t = tv[m][bj], g = gv[m][bj];
                    const f32x4 a0 = acc[ai][bj][m][0], a1 = acc[ai][bj][m][1];
                    float o[8];
#pragma unroll
                    for (int q = 0; q < 4; ++q) {
                        const float glo = __uint_as_float(g[q] << 16), ghi = __uint_as_float(g[q] & 0xffff0000u);
                        const float alo = q < 2 ? a0[2 * q] : a1[2 * q - 4], ahi = q < 2 ? a0[2 * q + 1] : a1[2 * q - 3];
                        float lo = glo * alo, hi = ghi * ahi;
                        if (MODE == 1) { lo += __uint_as_float(t[q] << 16); hi += __uint_as_float(t[q] & 0xffff0000u); }
                        o[2 * q] = lo; o[2 * q + 1] = hi;
                    }
                    u32x4 w; w.x = pk2(o[0], o[1]); w.y = pk2(o[2], o[3]); w.z = pk2(o[4], o[5]); w.w = pk2(o[6], o[7]);
                    *(u32x4*)(rowp + C_GR + bj * 128) = w;
                }
            }
        }
    }
};
template <bool F32OUT> struct EpiSsq {
    static constexpr bool PERM = true, AFTER_DRAIN = false, TWICE = false;
    bf16_t* P; int ccol; float* ssq; int pm0;
    DI void operator()(const f32x4 (&acc)[2][2][4][2], const Unit& u, int wr, int wc, int fr, int fq) const {
        const int rbase = (u.pm + pm0) * 256 + wr * 64 + fr, cb = u.pn * 256 + wc * 32 + 8 * fq;
#pragma unroll
        for (int ai = 0; ai < 2; ++ai)
#pragma unroll
            for (int m = 0; m < 4; ++m) {
                const int r = rbase + ai * 128 + m * 16;
                float s = 0.f;
#pragma unroll
                for (int bj = 0; bj < 2; ++bj) {
                    const f32x4 v0 = acc[ai][bj][m][0], v1 = acc[ai][bj][m][1];
                    s += (v0[0] * v0[0] + v0[1] * v0[1]) + (v0[2] * v0[2] + v0[3] * v0[3]) + (v1[0] * v1[0] + v1[1] * v1[1]) + (v1[2] * v1[2] + v1[3] * v1[3]);
                    if (F32OUT) { float* rowp = (float*)(P + (size_t)r * INW) + cb + bj * 128; *(f32x4*)rowp = v0; *(f32x4*)(rowp + 4) = v1; }
                    else { u32x4 w; w.x = pk2(v0[0], v0[1]); w.y = pk2(v0[2], v0[3]); w.z = pk2(v1[0], v1[1]); w.w = pk2(v1[2], v1[3]); *(u32x4*)(P + (size_t)r * INW + ccol + cb + bj * 128) = w; }
                }
                s += __shfl_xor(s, 16); s += __shfl_xor(s, 32);
                if (fq == 0) ssq[(size_t)r * 32 + u.pn * 4 + wc] = s;
            }
    }
};
struct EpiPart {
    static constexpr bool PERM = true, AFTER_DRAIN = false, TWICE = false;
    float* part;
    DI void operator()(const f32x4 (&acc)[2][2][4][2], const Unit& u, int wr, int wc, int fr, int fq) const {
        float* base = part + ((size_t)u.pm * 256 + wr * 64 + fr) * DM + u.pn * 256 + wc * 32 + 8 * fq;
#pragma unroll
        for (int ai = 0; ai < 2; ++ai)
#pragma unroll
            for (int m = 0; m < 4; ++m) {
                float* rowp = base + (size_t)(ai * 128 + m * 16) * DM;
#pragma unroll
                for (int bj = 0; bj < 2; ++bj) { *(f32x4*)(rowp + bj * 128) = acc[ai][bj][m][0]; *(f32x4*)(rowp + bj * 128 + 4) = acc[ai][bj][m][1]; }
            }
    }
};
#ifndef EPI_TWICE_UP
#define EPI_TWICE_UP false
#endif
struct EpiUp {
    static constexpr bool PERM = true, AFTER_DRAIN = false, TWICE = EPI_TWICE_UP;
    bf16_t* P; float* out; int pm0;
    DI void operator()(const f32x4 (&acc)[2][2][4][2], const Unit& u, int wr, int wc, int fr, int fq) const {
        const int rbase = (u.pm + pm0) * 256 + wr * 64 + fr, cb = u.pn * 256 + wc * 32 + 8 * fq;
#pragma unroll
        for (int ai = 0; ai < 2; ++ai)
#pragma unroll
            for (int m = 0; m < 4; ++m) {
                const int r = rbase + ai * 128 + m * 16;
                float* cst = nullptr;
                if (r < MP) { const int t = r & 4095; if (t >= 4094) cst = out + OFF_CP + ((size_t)(r >> 12) * 2 + (t - 4094)) * UPW; }
                else { const int t = r & 15; if (t >= 14) cst = out + OFF_CS + ((size_t)((r - MP) >> 4) * 2 + (t - 14)) * UPW; }
#pragma unroll
                for (int bj = 0; bj < 2; ++bj) {
                    const f32x4 v0 = acc[ai][bj][m][0], v1 = acc[ai][bj][m][1];
                    u32x4 w; w.x = pk2(v0[0], v0[1]); w.y = pk2(v0[2], v0[3]); w.z = pk2(v1[0], v1[1]); w.w = pk2(v1[2], v1[3]);
                    *(u32x4*)(P + (size_t)r * INW + C_UP + cb + bj * 128) = w;
                    if (cst) { *(f32x4*)(cst + cb + bj * 128) = v0; *(f32x4*)(cst + cb + bj * 128 + 4) = v1; }
                }
            }
    }
};

constexpr int TR_RS = 132, TR_BYTES = 32 * TR_RS * 4;
DI void transpose_item(const float* W, int K, int N, bf16_t* WT, LAS float* scr, int item, int lane, bool permq) {
    const int nblk = N / 128, kb = item / nblk, nb = item % nblk, k0 = 32 * kb, n0 = 128 * nb;
    const int c = lane & 31, kh = lane >> 5;
    const int pc = (permq && n0 < 2048) ? (32 * ((c >> 2) & 3) + 8 * (c & 3) + 4 * (c >> 4)) : 4 * c;
    const float* src = W + (size_t)(k0 + kh) * N + n0 + 4 * c;
    f32x4 v[16];
#pragma unroll
    for (int i = 0; i < 16; ++i) v[i] = *(const f32x4*)(src + (size_t)(2 * i) * N);
#pragma unroll
    for (int i = 0; i < 16; ++i) *(LAS f32x4*)(scr + (2 * i + kh) * TR_RS + pc) = v[i];
    asm volatile("s_waitcnt lgkmcnt(0)" ::: "memory");
    const int kc = lane & 3;
#pragma unroll
    for (int jj = 0; jj < 8; ++jj) { const int n = (lane >> 2) + 16 * jj; const LAS float* s = scr + (8 * kc) * TR_RS + n;
        u32x4 o; o.x = pk2(s[0 * TR_RS], s[1 * TR_RS]); o.y = pk2(s[2 * TR_RS], s[3 * TR_RS]); o.z = pk2(s[4 * TR_RS], s[5 * TR_RS]); o.w = pk2(s[6 * TR_RS], s[7 * TR_RS]);
        *(u32x4*)(WT + (size_t)(n0 + n) * K + k0 + 8 * kc) = o; }
    asm volatile("s_waitcnt lgkmcnt(0)" ::: "memory");
}
DI void mod_item(const float* cp, const float* cs, const float* wada, float* modp, LAS float* scr, int item, int lane) {
    const int s = item / 48, cb = item % 48, k0 = s * 128;
    for (int i = lane; i < 24 * 128; i += 64) { const int r = i >> 7, k = i & 127; const float c = r < 8 ? cp[r * DM + k0 + k] : cs[(r - 8) * DM + k0 + k]; scr[i] = c * sigmoidf_(c); }
    asm volatile("s_waitcnt lgkmcnt(0)" ::: "memory");
    f32x4 acc[24];
#pragma unroll
    for (int r = 0; r < 24; ++r) acc[r] = (f32x4){0.f, 0.f, 0.f, 0.f};
    const float* wp = wada + (size_t)k0 * MODW + cb * 256 + lane * 4;
    for (int k = 0; k < 128; k += 16) {
        f32x4 w[16];
#pragma unroll
        for (int i = 0; i < 16; ++i) w[i] = *(const f32x4*)(wp + (size_t)(k + i) * MODW);
#pragma unroll
        for (int r = 0; r < 24; ++r) {
#pragma unroll
            for (int i4 = 0; i4 < 4; ++i4) { const f32x4 c4 = *(const LAS f32x4*)(scr + r * 128 + k + 4 * i4); acc[r] += w[4 * i4] * c4.x + w[4 * i4 + 1] * c4.y + w[4 * i4 + 2] * c4.z + w[4 * i4 + 3] * c4.w; }
        }
    }
#pragma unroll
    for (int r = 0; r < 24; ++r) *(f32x4*)(modp + ((size_t)s * 24 + r) * MODW + cb * 256 + lane * 4) = acc[r];
    asm volatile("s_waitcnt lgkmcnt(0)" ::: "memory");
}
DI void norm_mod_row(const float* xrow, const float* g, const float* sc, const float* sh, bf16_t* orow, int lane) {
    f32x4 v[8]; float s = 0.f;
#pragma unroll
    for (int j = 0; j < 8; ++j) { v[j] = *(const f32x4*)(xrow + 4 * lane + 256 * j); s += (v[j].x * v[j].x + v[j].y * v[j].y) + (v[j].z * v[j].z + v[j].w * v[j].w); }
    const float rstd = rsqrtf(wave_sum(s) * (1.f / DM) + EPS);
#pragma unroll
    for (int j = 0; j < 8; ++j) {
        const int c = 4 * lane + 256 * j;
        const f32x4 gg = *(const f32x4*)(g + c), a = *(const f32x4*)(sc + c), b = *(const f32x4*)(sh + c);
        const f32x4 o = (v[j] * rstd) * gg * (a + 1.f) + b;
        u32x2 w; w.x = pk2(o.x, o.y); w.y = pk2(o.z, o.w); *(u32x2*)(orow + c) = w;
    }
}

template <bool DRY> DI void att_unit(bf16_t* P, const LAS float* bl, int unit, int lane) {
    asm volatile("" : "+v"(lane));
    const int qh = unit & 1, c = (unit >> 1) & 63, h = (unit >> 7) & 7, b = unit >> 10;
    bl += h * 257;
    const int r32 = lane & 31, hh = lane >> 5;
    const size_t rowb = (size_t)b * SEQ;
    const int t0 = c * 64 + qh * 32, qpos = t0 + r32;
    const bf16_t* qrow = P + (rowb + t0 + r32) * INW + C_AQ + 128 * h + 8 * hh;
    bf16x8 qf[8];
#pragma unroll
    for (int ks = 0; ks < 8; ++ks) qf[ks] = *(const bf16x8*)(qrow + 16 * ks);
    f32x16 o[4];
#pragma unroll
    for (int d = 0; d < 4; ++d)
#pragma unroll
        for (int i = 0; i < 16; ++i) o[d][i] = 0.f;
    float mrun = -1e30f, lrun = 0.f;
    const int k0 = c * 64 - 512 < 0 ? 0 : c * 64 - 512, k1 = c * 64 + 64;
    bf16x8 kf[8];
    {
#pragma unroll
        for (int ks = 0; ks < 8; ++ks) kf[ks] = *(const bf16x8*)(P + (rowb + k0 + ((h * 8 + ks) >> 1)) * INW + C_AK + ((h * 8 + ks) & 1) * 512 + lane * 8); }
    bf16x8 vf[2][4];
#pragma unroll
    for (int s2 = 0; s2 < 2; ++s2)
#pragma unroll
        for (int d = 0; d < 4; ++d) vf[s2][d] = *(const bf16x8*)(P + (rowb + k0 + 16 * s2 + ((h * 4 + d) >> 1)) * INW + C_AV + ((h * 4 + d) & 1) * 512 + lane * 8);
    for (int key0 = k0; key0 < k1; key0 += 32) {
        f32x16 s;
#pragma unroll
        for (int i = 0; i < 16; ++i) s[i] = 0.f;
#pragma unroll
        for (int ks = 0; ks < 8; ++ks) s = MFMA32(kf[ks], qf[ks], s);
        {
            const int kn0 = key0 + 32 < k1 ? key0 + 32 : key0;
#pragma unroll
            for (int ks = 0; ks < 8; ++ks) kf[ks] = *(const bf16x8*)(P + (rowb + kn0 + ((h * 8 + ks) >> 1)) * INW + C_AK + ((h * 8 + ks) & 1) * 512 + lane * 8); }
        float mx = -1e30f;
        if (key0 + 159 <= t0) {
            const float b0 = bl[0];
#pragma unroll
            for (int i = 0; i < 16; ++i) { s[i] += b0; mx = fmaxf(mx, s[i]); }
        } else {
#pragma unroll
            for (int i = 0; i < 16; ++i) { int idx = key0 + crow(i, hh) - qpos + 128; idx = idx < 0 ? 0 : idx; s[i] += bl[idx]; mx = fmaxf(mx, s[i]); }
        }
        mx = fmaxf(mx, __shfl_xor(mx, 32));
        if (__builtin_amdgcn_ballot_w64(mx - mrun > 8.f) != 0ull) {
            const float mnew = fmaxf(mrun, mx), alpha = __expf(mrun - mnew);
            lrun *= alpha; mrun = mnew;
#pragma unroll
            for (int d = 0; d < 4; ++d)
#pragma unroll
                for (int i = 0; i < 16; ++i) o[d][i] *= alpha;
        }
        float psum = 0.f;
#pragma unroll
        for (int i = 0; i < 16; ++i) { const float p = __expf(s[i] - mrun); psum += p; s[i] = p; }
        lrun += psum;
#pragma unroll
        for (int s2 = 0; s2 < 2; ++s2) {
            const bf16x8 xs = pack_step(s, s2);
#pragma unroll
            for (int d = 0; d < 4; ++d) o[d] = MFMA32(vf[s2][d], xs, o[d]);
        }
        {
            const int kn0 = key0 + 32 < k1 ? key0 + 32 : key0;
#pragma unroll
            for (int s2 = 0; s2 < 2; ++s2)
#pragma unroll
                for (int d = 0; d < 4; ++d) vf[s2][d] = *(const bf16x8*)(P + (rowb + kn0 + 16 * s2 + ((h * 4 + d) >> 1)) * INW + C_AV + ((h * 4 + d) & 1) * 512 + lane * 8);
        }
    }
    const float inv = 1.f / (lrun + __shfl_xor(lrun, 32));
    bf16_t* orow = P + (rowb + t0 + r32) * INW + C_AQ + 128 * h + 4 * hh;
    if (!DRY || lrun < -1.f)
#pragma unroll
    for (int d = 0; d < 4; ++d)
#pragma unroll
        for (int g = 0; g < 4; ++g) { u32x2 w; w.x = pk2(o[d][4 * g] * inv, o[d][4 * g + 1] * inv); w.y = pk2(o[d][4 * g + 2] * inv, o[d][4 * g + 3] * inv); *(u32x2*)(orow + 32 * d + 8 * g) = w; }
}

constexpr int RT_RS = 272, RT_QLB = 64 * RT_RS, RT_BUFB = 2 * RT_QLB + 16384, RT_ORS = 528, RT_LDS0 = 8448;
DI void ret_stage_qk(LAS unsigned char* buf, const u32x4 (&qn)[2], const u32x4 (&kn)[2], int tid, float lg) {
#pragma unroll
    for (int it = 0; it < 2; ++it) {
        const int piece = tid + 512 * it, m = piece >> 4, ch = piece & 15;
        *(LAS u32x4*)(buf + m * RT_RS + ch * 16) = qn[it];
        *(LAS u32x4*)(buf + RT_QLB + m * RT_RS + ch * 16) = kn[it];
        const float dk = __builtin_amdgcn_exp2f((float)(63 - m) * lg);
        const int m16 = m >> 4, t4 = m & 15, khh = (t4 >> 2) & 1, j = ((t4 >> 3) << 2) | (t4 & 3), db = ch >> 2, dl0 = (ch & 3) * 8;
        LAS bf16_t* dst = (LAS bf16_t*)(buf + 2 * RT_QLB) + ((((m16 * 4 + db) * 2 + khh) * 32 + dl0) * 8 + j);
#pragma unroll
        for (int q = 0; q < 4; ++q) {
            dst[(2 * q) * 8] = (bf16_t)f2bf(__uint_as_float(kn[it][q] << 16) * dk);
            dst[(2 * q + 1) * 8] = (bf16_t)f2bf(__uint_as_float(kn[it][q] & 0xffff0000u) * dk);
        }
    }
}
template <bool DRY> DI void ret_prompt_unit(bf16_t* P, float* out, int b, int h, LAS unsigned char* lds0, int tid) {
    asm volatile("" : "+v"(tid));
    LAS unsigned char* lds = lds0 + RT_LDS0;
    LAS unsigned char* XA = lds + 2 * RT_BUFB;
    const int w = __builtin_amdgcn_readfirstlane(tid >> 6);
    const float lg = log2f(1.f - exp2f(-5.f - (float)h));
    const float dsc = __builtin_amdgcn_exp2f(64.f * lg), g1 = __builtin_amdgcn_exp2f(lg), g8 = __builtin_amdgcn_exp2f(8.f * lg);
    f32x16 S[4];
#pragma unroll
    for (int d = 0; d < 4; ++d)
#pragma unroll
        for (int i = 0; i < 16; ++i) S[d][i] = 0.f;
    bf16x8 vf[4];
    {
        const size_t R0 = (size_t)b * SEQ;
        const int lane = tid & 63, r32 = lane & 31, hh = lane >> 5;
        u32x4 qn[2], kn[2];
#pragma unroll
        for (int it = 0; it < 2; ++it) { const int piece = tid + 512 * it, m = piece >> 4, ch = piece & 15;
            qn[it] = *(const u32x4*)(P + (R0 + m) * INW + C_RQ + 128 * h + 8 * ch); kn[it] = *(const u32x4*)(P + (R0 + m) * INW + C_RK + 128 * h + 8 * ch); }
#pragma unroll
        for (int m16 = 0; m16 < 4; ++m16) vf[m16] = *(const bf16x8*)(P + (R0 + 16 * m16 + hh * 8 + (r32 >> 2)) * INW + C_RV + 256 * h + 32 * w + (r32 & 3) * 8);
        __syncthreads();
        ret_stage_qk(lds, qn, kn, tid, lg);
        __syncthreads();
    }
    for (int c = 0; c < 64; ++c) {
        asm volatile("" : "+v"(tid));
        const int lane = tid & 63, r32 = lane & 31, hh = lane >> 5;
        const size_t R0 = (size_t)b * SEQ + 64 * c, R1 = R0 + 64;
        LAS unsigned char* cur = lds + (c & 1) * RT_BUFB; LAS unsigned char* nxt = lds + ((c & 1) ^ 1) * RT_BUFB;
        const LAS unsigned char* QL = cur; const LAS unsigned char* KL = cur + RT_QLB; const LAS bf16_t* KD = (const LAS bf16_t*)(cur + 2 * RT_QLB);
        {
            const int tr = w >> 1, tc0 = 2 * (w & 1), i16 = lane & 15, kq = lane >> 4;
            f32x4 xt[2] = {(f32x4){0.f, 0.f, 0.f, 0.f}, (f32x4){0.f, 0.f, 0.f, 0.f}};
            const LAS unsigned char* kp = KL + (16 * tr + i16) * RT_RS + 16 * kq;
            const LAS unsigned char* qp0 = QL + (16 * tc0 + i16) * RT_RS + 16 * kq;
#pragma unroll
            for (int ks = 0; ks < 4; ++ks) {
                const bf16x8 kf = *(const LAS bf16x8*)(kp + 64 * ks);
#pragma unroll
                for (int tt = 0; tt < 2; ++tt) { const bf16x8 qf = *(const LAS bf16x8*)(qp0 + tt * 16 * RT_RS + 64 * ks); xt[tt] = __builtin_amdgcn_mfma_f32_16x16x32_bf16(kf, qf, xt[tt], 0, 0, 0); }
            }
#pragma unroll
            for (int tt = 0; tt < 2; ++tt) {
                const int tc = tc0 + tt; const float nm = (float)((16 * tc + i16) - (16 * tr + 4 * kq));
                float xv[4];
#pragma unroll
                for (int e = 0; e < 4; ++e) xv[e] = xt[tt][e] * __builtin_amdgcn_exp2f(fabsf(nm - (float)e) * lg);
                u32x2 pk; pk.x = pk2(xv[0], xv[1]); pk.y = pk2(xv[2], xv[3]);
                *(LAS u32x2*)(XA + (((tc >> 1) * 4 + tr) * 64 + ((tc & 1) * 16 + i16) + 32 * (kq & 1)) * 16 + (kq >> 1) * 8) = pk;
            }
        }
        f32x16 O[2];
#pragma unroll
        for (int nb = 0; nb < 2; ++nb)
#pragma unroll
            for (int i = 0; i < 16; ++i) O[nb][i] = 0.f;
#pragma unroll
        for (int db = 0; db < 4; ++db)
#pragma unroll
            for (int s = 0; s < 2; ++s) {
                const bf16x8 xs = pack_step(S[db], s);
#pragma unroll
                for (int nb = 0; nb < 2; ++nb) {
                    const LAS unsigned char* qp = QL + (32 * nb + r32) * RT_RS + (32 * db + 16 * s + 4 * hh) * 2;
                    const u32x2 lo = *(const LAS u32x2*)qp, hi = *(const LAS u32x2*)(qp + 16);
                    u32x4 pq; pq.x = lo.x; pq.y = lo.y; pq.z = hi.x; pq.w = hi.y;
                    O[nb] = MFMA32(__builtin_bit_cast(bf16x8, pq), xs, O[nb]);
                }
                if (s == 1) asm volatile("" ::: "memory");
            }
        {
            float fg = __builtin_amdgcn_exp2f((float)(4 * hh + 1) * lg);
#pragma unroll
            for (int nb = 0; nb < 2; ++nb)
#pragma unroll
                for (int g = 0; g < 4; ++g) {
                    float fe = fg;
#pragma unroll
                    for (int e = 0; e < 4; ++e) { O[nb][4 * g + e] *= fe; fe *= g1; }
                    fg *= g8;
                }
        }
        u32x4 qn[2], kn[2];
#pragma unroll
        for (int it = 0; it < 2; ++it) { const int piece = tid + 512 * it, m = piece >> 4, ch = piece & 15;
            qn[it] = *(const u32x4*)(P + (R1 + m) * INW + C_RQ + 128 * h + 8 * ch); kn[it] = *(const u32x4*)(P + (R1 + m) * INW + C_RK + 128 * h + 8 * ch); }
        __syncthreads();
#pragma unroll
        for (int nb = 0; nb < 2; ++nb)
#pragma unroll
            for (int m16 = 0; m16 < 4; ++m16) { const bf16x8 xa = *(const LAS bf16x8*)(XA + ((nb * 4 + m16) * 64 + lane) * 16); O[nb] = MFMA32(xa, vf[m16], O[nb]); }
#pragma unroll
        for (int db = 0; db < 4; ++db) {
#pragma unroll
            for (int i = 0; i < 16; ++i) S[db][i] *= dsc;
#pragma unroll
            for (int m16 = 0; m16 < 4; ++m16) { const bf16x8 kd = *(const LAS bf16x8*)(KD + ((m16 * 4 + db) * 64 + lane) * 8); S[db] = MFMA32(kd, vf[m16], S[db]); }
        }
        asm volatile("" ::: "memory");
#pragma unroll
        for (int m16 = 0; m16 < 4; ++m16) vf[m16] = *(const bf16x8*)(P + (R1 + 16 * m16 + hh * 8 + (r32 >> 2)) * INW + C_RV + 256 * h + 32 * w + (r32 & 3) * 8);
        const int on = tid >> 3, oseg = tid & 7;
        bf16_t* orow = P + (R0 + on) * INW + 256 * h + 32 * oseg;
        u32x4 gr[4];
#pragma unroll
        for (int j = 0; j < 4; ++j) gr[j] = *(const u32x4*)(orow + C_RG + 8 * j);
        __syncthreads();
        LAS bf16_t* olb = (LAS bf16_t*)(cur + (4 * hh) * RT_ORS) + 32 * w + r32;
#pragma unroll
        for (int nb = 0; nb < 2; ++nb)
#pragma unroll
            for (int i = 0; i < 16; ++i) {
                constexpr int dummy = 0; (void)dummy;
                const int cn = 32 * nb + (i & 3) + 8 * (i >> 2);
                olb[cn * (RT_ORS / 2)] = (bf16_t)f2bf(O[nb][i]);
            }
        ret_stage_qk(nxt, qn, kn, tid, lg);
        __syncthreads();
        {
            u32x4 ovs[4]; float sq = 0.f;
#pragma unroll
            for (int j = 0; j < 4; ++j) { ovs[j] = *(const LAS u32x4*)(cur + on * RT_ORS + oseg * 64 + j * 16);
#pragma unroll
                for (int q = 0; q < 4; ++q) { const float lo = __uint_as_float(ovs[j][q] << 16), hi = __uint_as_float(ovs[j][q] & 0xffff0000u); sq += lo * lo + hi * hi; } }
            sq += __shfl_xor(sq, 1); sq += __shfl_xor(sq, 2); sq += __shfl_xor(sq, 4);
            const float rstd = rsqrtf(sq * (1.f / 256.f) + EPS);
#pragma unroll
            for (int j = 0; j < 4; ++j) {
                const u32x4 ov = ovs[j];
                u32x4 wv4;
#pragma unroll
                for (int q = 0; q < 4; ++q) {
                    const float lo = __uint_as_float(ov[q] << 16) * rstd * __uint_as_float(gr[j][q] << 16);
                    const float hi = __uint_as_float(ov[q] & 0xffff0000u) * rstd * __uint_as_float(gr[j][q] & 0xffff0000u);
                    wv4[q] = pk2(lo, hi);
                }
                if (!DRY || dsc < 0.f) *(u32x4*)(orow + C_RV + 8 * j) = wv4;
            }
        }
    }
    const int lane = tid & 63, r32 = lane & 31, hh = lane >> 5;
    float* so = out + OFF_RP + ((size_t)(b * 8 + h) * 128) * 256 + 32 * w + r32;
#pragma unroll
    for (int db = 0; db < 4; ++db)
#pragma unroll
        for (int i = 0; i < 16; ++i) if (!DRY || dsc < 0.f) so[(size_t)(32 * db + crow(i, hh)) * 256] = S[db][i];
    __syncthreads();
}

DI void ret_sample_unit(bf16_t* P, const float* state_in, float* out, int sb, int h, LAS unsigned char* lds, int tid) {
    asm volatile("" : "+v"(tid));
    LAS float* qs = (LAS float*)lds; LAS float* ks = qs + 2048; LAS float* vs = ks + 2048; LAS float* As = vs + 4096; LAS float* part = As + 256;
    const size_t R0 = (size_t)MP + 16 * sb;
    const float lg = log2f(1.f - exp2f(-5.f - (float)h));
    __syncthreads();
    for (int i = tid; i < 2048; i += 512) { const int t = i >> 7, d = i & 127; qs[i] = bf2f(P[(R0 + t) * INW + C_RQ + 128 * h + d]); ks[i] = bf2f(P[(R0 + t) * INW + C_RK + 128 * h + d]); }
    for (int i = tid; i < 4096; i += 512) { const int t = i >> 8, e = i & 255; vs[i] = bf2f(P[(R0 + t) * INW + C_RV + 256 * h + e]); }
    __syncthreads();
    if (tid < 256) { const int n = tid >> 4, m = tid & 15; float a = 0.f;
#pragma unroll 4
        for (int d = 0; d < 128; ++d) a += qs[n * 128 + d] * ks[m * 128 + d]; const int dd = n > m ? n - m : m - n; As[tid] = a * exp2f((float)dd * lg); }
    __syncthreads();
    const int e = tid & 255, hf = tid >> 8;
    const float* S0 = state_in + ((size_t)(sb * 8 + h) * 128) * 256 + e;
    float o[8];
#pragma unroll
    for (int i = 0; i < 8; ++i) o[i] = 0.f;
#pragma unroll 4
    for (int d = 0; d < 128; ++d) { const float s = S0[(size_t)d * 256];
#pragma unroll
        for (int i = 0; i < 8; ++i) o[i] += qs[(8 * hf + i) * 128 + d] * s; }
    float vreg[16];
#pragma unroll
    for (int m = 0; m < 16; ++m) vreg[m] = vs[m * 256 + e];
#pragma unroll
    for (int i = 0; i < 8; ++i) { const int n = 8 * hf + i; float a = o[i] * exp2f((float)(n + 1) * lg);
#pragma unroll
        for (int m = 0; m < 16; ++m) a += As[n * 16 + m] * vreg[m];
        o[i] = a; }
    { const float d16 = exp2f(16.f * lg); float* so = out + OFF_RS + ((size_t)(sb * 8 + h) * 128) * 256 + e;
#pragma unroll
      for (int m = 0; m < 16; ++m) vreg[m] *= exp2f((float)(15 - m) * lg);
#pragma unroll 2
      for (int d = 64 * hf; d < 64 * hf + 64; ++d) { float a = d16 * S0[(size_t)d * 256];
#pragma unroll
          for (int m = 0; m < 16; ++m) a += ks[m * 128 + d] * vreg[m];
          so[(size_t)d * 256] = a; } }
    const int wv = tid >> 6, lane = tid & 63;
#pragma unroll
    for (int i = 0; i < 8; ++i) { const float q = wave_sum(o[i] * o[i]); if (lane == 0) part[(8 * hf + i) * 4 + (wv & 3)] = q; }
    __syncthreads();
#pragma unroll
    for (int i = 0; i < 8; ++i) { const int n = 8 * hf + i; const float rstd = rsqrtf(((part[n * 4] + part[n * 4 + 1]) + (part[n * 4 + 2] + part[n * 4 + 3])) * (1.f / 256.f) + EPS);
        bf16_t* rp = P + (R0 + n) * INW + 256 * h + e; rp[C_RV] = (bf16_t)f2bf(o[i] * rstd * bf2f(rp[C_RG])); }
    __syncthreads();
}
DI void att_sample_unit(bf16_t* P, const float* ck, const float* cv, const float* relb, int sb, int h, LAS unsigned char* lds, int tid) {
    asm volatile("" : "+v"(tid));
    LAS float* qs = (LAS float*)lds; LAS float* sc = qs + 2048;
    const size_t R0 = (size_t)MP + 16 * sb;
    __syncthreads();
    for (int i = tid; i < 2048; i += 512) { const int t = i >> 7, d = i & 127; qs[i] = bf2f(P[(R0 + t) * INW + C_AQ + 128 * h + d]); }
    __syncthreads();
    for (int key = tid; key < 528; key += 512) {
        float acc[16];
#pragma unroll
        for (int q = 0; q < 16; ++q) acc[q] = 0.f;
        if (key < 512) {
            const float* kr = ck + (((size_t)sb * 512 + key) * 8 + h) * 128;
            for (int d = 0; d < 128; d += 4) { const f32x4 kv = *(const f32x4*)(kr + d);
#pragma unroll
                for (int q = 0; q < 16; ++q) { const f32x4 qq = *(const LAS f32x4*)(qs + q * 128 + d); acc[q] += (kv.x * qq.x + kv.y * qq.y) + (kv.z * qq.z + kv.w * qq.w); } }
        } else {
            const bf16_t* kr = P + (R0 + key - 512) * INW + C_AK + 128 * h;
            for (int d = 0; d < 128; ++d) { const float kv = bf2f(kr[d]);
#pragma unroll
                for (int q = 0; q < 16; ++q) acc[q] += kv * qs[q * 128 + d]; }
        }
        const int kpos = key < 512 ? 3584 + key : 4096 + (key - 512);
#pragma unroll
        for (int q = 0; q < 16; ++q) { int rel = kpos - (4096 + q); rel = rel < -128 ? -128 : (rel > 128 ? 128 : rel); sc[q * 528 + key] = acc[q] + relb[h * 257 + rel + 128]; }
    }
    __syncthreads();
    { const int wv = tid >> 6, lane = tid & 63;
      for (int q = 2 * wv; q < 2 * wv + 2; ++q) {
          float mx = -1e30f; for (int k = lane; k < 528; k += 64) mx = fmaxf(mx, sc[q * 528 + k]);
#pragma unroll
          for (int o = 1; o < 64; o <<= 1) mx = fmaxf(mx, __shfl_xor(mx, o));
          float sm = 0.f; for (int k = lane; k < 528; k += 64) { const float p = __expf(sc[q * 528 + k] - mx); sc[q * 528 + k] = p; sm += p; }
          sm = wave_sum(sm); const float inv = 1.f / sm;
          for (int k = lane; k < 528; k += 64) sc[q * 528 + k] *= inv;
      } }
    __syncthreads();
    { const int d4 = (tid & 31) * 4, q = tid >> 5;
      f32x4 a = (f32x4){0.f, 0.f, 0.f, 0.f};
      const float* vr = cv + ((size_t)sb * 512 * 8 + h) * 128 + d4;
#pragma unroll 1
      for (int k0 = 0; k0 < 512; k0 += 8) {
          f32x4 vv[8];
#pragma unroll
          for (int i = 0; i < 8; ++i) vv[i] = *(const f32x4*)(vr + (size_t)(k0 + i) * 1024);
          const f32x4 p0 = *(const LAS f32x4*)(sc + q * 528 + k0), p1 = *(const LAS f32x4*)(sc + q * 528 + k0 + 4);
          a += (vv[0] * p0.x + vv[1] * p0.y) + (vv[2] * p0.z + vv[3] * p0.w) + (vv[4] * p1.x + vv[5] * p1.y) + (vv[6] * p1.z + vv[7] * p1.w);
      }
      for (int k = 0; k < 16; ++k) { const bf16_t* vp = P + (R0 + k) * INW + C_AV + 128 * h + d4; const float p = sc[q * 528 + 512 + k];
          a.x += bf2f(vp[0]) * p; a.y += bf2f(vp[1]) * p; a.z += bf2f(vp[2]) * p; a.w += bf2f(vp[3]) * p; }
      u32x2 w; w.x = pk2(a.x, a.y); w.y = pk2(a.z, a.w);
      *(u32x2*)(P + (R0 + q) * INW + C_AQ + 128 * h + d4) = w; }
    __syncthreads();
}

#define XB_TMO      128
#define XB_XCNT(j)  (256  + 64 * (j))
#define XB_XSUB(j)  (1280 + 64 * (j))
#define XB_XGEN(j)  (2304 + 64 * (j))
#define XB_TOP      3328
#define XB_TOPGEN   3392
#define XCD_BAR_WORDS 3456
#define XB_SPIN_CAP (1u << 18)

__device__ __forceinline__ unsigned xb_ld(unsigned* p)              { return __hip_atomic_load(p, __ATOMIC_RELAXED, __HIP_MEMORY_SCOPE_AGENT); }
__device__ __forceinline__ unsigned xb_add(unsigned* p, unsigned v) { return __hip_atomic_fetch_add(p, v, __ATOMIC_RELAXED, __HIP_MEMORY_SCOPE_AGENT); }
__device__ __forceinline__ unsigned xb_xcc_id() { return (unsigned)__builtin_amdgcn_s_getreg((3 << 11) | 20) & 0xFu; }
#define XB_SPIN(cond, bar) do { unsigned _sp = 0; while (cond) { __builtin_amdgcn_s_sleep(1); \
    if ((++_sp & 255u) == 0u) { if (xb_ld(&(bar)[XB_TMO])) break; if (_sp > XB_SPIN_CAP) { atomicAdd(&(bar)[XB_TMO], 1u); break; } } } } while (0)

struct XcdBarrier {
    unsigned* bar; unsigned x;
    volatile LAS unsigned* st;
};

__device__ __forceinline__ XcdBarrier xcd_barrier_post(unsigned* bar, volatile LAS unsigned* st) {
    XcdBarrier b; b.bar = bar; b.x = xb_xcc_id(); b.st = st;
    if (threadIdx.x == 0) (void)xb_add(&bar[XB_XCNT(b.x)], 1u);
    return b;
}
__device__ __forceinline__ void xcd_barrier_complete(unsigned* bar, unsigned x, unsigned& nloc, unsigned& nx) {
    const unsigned G = gridDim.x * gridDim.y * gridDim.z;
    unsigned sum, cnt, mine, sp = 0u;
    for (;;) {
        sum = 0u; cnt = 0u; mine = 0u;
#pragma unroll
        for (unsigned j = 0; j < 16; ++j) { const unsigned c = xb_ld(&bar[XB_XCNT(j)]); sum += c; cnt += (c > 0u) ? 1u : 0u; mine = (j == x) ? c : mine; }
        if (sum == G) break;
        __builtin_amdgcn_s_sleep(1);
        if ((++sp & 255u) == 0u) { if (xb_ld(&bar[XB_TMO])) break; if (sp > XB_SPIN_CAP) { atomicAdd(&bar[XB_TMO], 1u); break; } }
    }
    nloc = mine > 0u ? mine : 1u; nx = cnt > 0u ? cnt : 1u;
}

__device__ __forceinline__ void xcd_barrier(const XcdBarrier& b) {
    asm volatile("s_waitcnt vmcnt(0)" ::: "memory");
    __syncthreads();
    if (threadIdx.x == 0) {
        unsigned* bar = b.bar;
        __builtin_amdgcn_s_waitcnt(0);
        unsigned nloc = b.st[0], nx = b.st[1];
        if (nloc == 0u) { xcd_barrier_complete(bar, b.x, nloc, nx); b.st[0] = nloc; b.st[1] = nx; }
        const unsigned old = xb_add(&bar[XB_XSUB(b.x)], 1u);
        const unsigned gen = old / nloc;
        if (old + 1u == (gen + 1u) * nloc) {
            __builtin_amdgcn_fence(__ATOMIC_RELEASE, "agent");
            asm volatile("s_waitcnt vmcnt(0)" ::: "memory");
            const unsigned og = xb_add(&bar[XB_TOP], 1u);
            const unsigned tg = og / nx;
            if (og + 1u == (tg + 1u) * nx) xb_add(&bar[XB_TOPGEN], 1u);
            else XB_SPIN(xb_ld(&bar[XB_TOPGEN]) == tg, bar);
            __builtin_amdgcn_fence(__ATOMIC_ACQUIRE, "agent");
            xb_add(&bar[XB_XGEN(b.x)], 1u);
            asm volatile("s_waitcnt vmcnt(0)" ::: "memory");
        } else {
            XB_SPIN(xb_ld(&bar[XB_XGEN(b.x)]) == gen, bar);
            __builtin_amdgcn_fence(__ATOMIC_ACQUIRE, "agent");
            asm volatile("s_waitcnt vmcnt(0)" ::: "memory");
        }
    }
    __syncthreads();
}


struct Ctx { bf16_t *P, *HS, *WBR, *WBA, *WOUT, *WUP, *WDN; float *out, *Y, *SSQ, *MOD, *PART; const float *x_p, *x_s, *g_post1, *g_pre2, *g_post2, *conv_w, *conv_b, *state_conv; unsigned* subbar; LAS unsigned char* lds; XcdBarrier xbar; };
DI void sub_barrier(unsigned* cnt, unsigned nblk, unsigned& gen) {
    asm volatile("s_waitcnt vmcnt(0)" ::: "memory");
    __syncthreads();
    ++gen;
    if (threadIdx.x == 0) {
        __builtin_amdgcn_fence(__ATOMIC_RELEASE, "agent");
        asm volatile("s_waitcnt vmcnt(0)" ::: "memory");
        (void)__hip_atomic_fetch_add(cnt, 1u, __ATOMIC_RELAXED, __HIP_MEMORY_SCOPE_AGENT);
        const unsigned want = gen * nblk; unsigned sp = 0;
        while (__hip_atomic_load(cnt, __ATOMIC_RELAXED, __HIP_MEMORY_SCOPE_AGENT) < want) { __builtin_amdgcn_s_sleep(2); if (++sp > (1u << 22)) break; }
        __builtin_amdgcn_fence(__ATOMIC_ACQUIRE, "agent");
        asm volatile("s_waitcnt vmcnt(0)" ::: "memory");
    }
    __syncthreads();
}
DI bf16_t* h_row(const Ctx& c, int r) { return r < 16384 ? c.P + (size_t)(r + 16384) * INW + C_H : (r < 32768 ? c.P + (size_t)(r - 16384) * INW + C_H : c.HS + (size_t)(r - 32768) * INW); }
template <bool SUB> DI void post_mixer(const Ctx& c, int tile_lo, int ntile, int G, int cb, unsigned& sgen) {
#define PM_SYNC() do { if (SUB) sub_barrier(c.subbar, (unsigned)G, sgen); else xcd_barrier(c.xbar); } while (0)
#define PM_TID() int tid = threadIdx.x; asm volatile("" : "+v"(tid)); const int lane = tid & 63, wv = __builtin_amdgcn_readfirstlane(tid >> 6), gw = cb * 8 + wv; (void)lane; (void)gw
    bf16_t* P = c.P; LAS unsigned char* lds = c.lds;
    const int NGW = G * 8, row_lo = tile_lo * 256, row_hi = row_lo + ntile * 256;
    {
        pg8::Gemm g{P + (size_t)row_lo * INW + C_RV, INW, c.WBR, DM, -1, nullptr}; pg8::StaticOrder S; S.init(ntile, 8, G, cb);
        EpiMerge<0> E{P, tile_lo};
        pg8::gemm_phase<EpiMerge<0>, pg8::StaticOrder, true, true>(lds, g, S, E);
    }
    {
        pg8::Gemm g{P + (size_t)row_lo * INW + C_AQ, INW, c.WBA, 1024, -1, nullptr}; pg8::StaticOrder S; S.init(ntile, 8, G, cb);
        EpiMerge<1> E{P, tile_lo};
        pg8::gemm_phase<EpiMerge<1>, pg8::StaticOrder, true, true>(lds, g, S, E);
    }
    PM_SYNC();
    {
        pg8::Gemm g{P + (size_t)row_lo * INW + C_GR, INW, c.WOUT, DM, -1, nullptr}; pg8::StaticOrder S; S.init(ntile, 8, G, cb);
        EpiSsq<false> E{P, 0, c.SSQ, tile_lo};
        pg8::gemm_phase<EpiSsq<false>, pg8::StaticOrder, true, true>(lds, g, S, E);
    }
    PM_SYNC();
    { PM_TID(); for (int r = row_lo + gw; r < row_hi; r += NGW) {
        const float* xr = r < MP ? c.x_p + (size_t)r * DM : c.x_s + (size_t)(r - MP) * DM;
        const float* md = c.MOD + (size_t)mod_row(r) * MODW;
        const bf16_t* zr = P + (size_t)r * INW;
        const float q = lane < 32 ? c.SSQ[(size_t)r * 32 + lane] : 0.f;
        const float rstd1 = rsqrtf(wave_sum(q) * (1.f / DM) + EPS);
        f32x4 v[8]; float s = 0.f;
#pragma unroll
        for (int j = 0; j < 8; ++j) {
            const int cc = 4 * lane + 256 * j;
            const u32x2 zb = *(const u32x2*)(zr + cc);
            const f32x4 z = (f32x4){__uint_as_float(zb.x << 16), __uint_as_float(zb.x & 0xffff0000u), __uint_as_float(zb.y << 16), __uint_as_float(zb.y & 0xffff0000u)};
            const f32x4 xx = *(const f32x4*)(xr + cc), gp = *(const f32x4*)(c.g_post1 + cc), gt = *(const f32x4*)(md + MOD_GT1 + cc);
            v[j] = xx + gt * (z * rstd1 * gp);
            *(f32x4*)(c.Y + (size_t)r * DM + cc) = v[j];
            s += (v[j].x * v[j].x + v[j].y * v[j].y) + (v[j].z * v[j].z + v[j].w * v[j].w);
        }
        const float rstd2 = rsqrtf(wave_sum(s) * (1.f / DM) + EPS);
        bf16_t* orow = P + (size_t)r * INW + C_U2;
#pragma unroll
        for (int j = 0; j < 8; ++j) {
            const int cc = 4 * lane + 256 * j;
            const f32x4 gg = *(const f32x4*)(c.g_pre2 + cc), sc = *(const f32x4*)(md + MOD_SC2 + cc), sh = *(const f32x4*)(md + MOD_SH2 + cc);
            const f32x4 o = (v[j] * rstd2) * gg * (sc + 1.f) + sh;
            u32x2 w; w.x = pk2(o.x, o.y); w.y = pk2(o.z, o.w); *(u32x2*)(orow + cc) = w;
        }
    } }
    PM_SYNC();
    const int nparts = ntile >= 2 ? 2 : 1, ptiles = ntile / nparts;
    for (int hfi = 0; hfi < nparts * REP_FFN; ++hfi) {
        const int hf = hfi % nparts;
        const int pm0 = tile_lo + hf * ptiles, nM = ptiles, prow_lo = pm0 * 256;
        {
            pg8::Gemm g{P + (size_t)prow_lo * INW + C_U2, INW, c.WUP, DM, -1, nullptr}; pg8::StaticOrder S; S.init(nM, UPW / 256, G, cb);
            EpiUp E{P, c.out, pm0};
            pg8::gemm_phase<EpiUp, pg8::StaticOrder, true, true>(lds, g, S, E);
        }
        PM_SYNC();
        {   PM_TID();
            const int nitems = (nM * 16) * 11;
            for (int it = gw; it < nitems; it += NGW) {
                const int rg = it / 11, ch = it % 11, r0 = prow_lo + rg * 16, c0 = ch * 512 + lane * 8;
                float wv_[3][8], wg_[3][8], bv_[8], bg_[8];
#pragma unroll
                for (int t = 0; t < 3; ++t)
#pragma unroll
                    for (int e = 0; e < 8; ++e) { wv_[t][e] = c.conv_w[(size_t)t * UPW + c0 + e]; wg_[t][e] = c.conv_w[(size_t)t * UPW + DFF + c0 + e]; }
#pragma unroll
                for (int e = 0; e < 8; ++e) { bv_[e] = c.conv_b[c0 + e]; bg_[e] = c.conv_b[DFF + c0 + e]; }
                float pv[2][8], pg[2][8];
                const bool smp = r0 >= MP;
                const int tfirst = smp ? 0 : (r0 & 4095);
#pragma unroll
                for (int k = 0; k < 2; ++k) {
                    if (smp) { const float* sp = c.state_conv + ((size_t)((r0 - MP) >> 4) * 2 + k) * UPW + c0;
#pragma unroll
                        for (int e = 0; e < 8; ++e) { pv[k][e] = sp[e]; pg[k][e] = sp[DFF + e]; } }
                    else if (tfirst == 0) {
#pragma unroll
                        for (int e = 0; e < 8; ++e) { pv[k][e] = 0.f; pg[k][e] = 0.f; } }
                    else { const bf16_t* up = P + (size_t)(r0 - 2 + k) * INW + C_UP + c0; const u32x4 a4 = *(const u32x4*)up, b4 = *(const u32x4*)(up + DFF);
#pragma unroll
                        for (int q = 0; q < 4; ++q) { pv[k][2 * q] = __uint_as_float(a4[q] << 16); pv[k][2 * q + 1] = __uint_as_float(a4[q] & 0xffff0000u); pg[k][2 * q] = __uint_as_float(b4[q] << 16); pg[k][2 * q + 1] = __uint_as_float(b4[q] & 0xffff0000u); } }
                }
                bf16_t* hp = h_row(c, r0) + c0;
                u32x4 na[4], nb[4];
#pragma unroll
                for (int q = 0; q < 4; ++q) { const bf16_t* up = P + (size_t)(r0 + q) * INW + C_UP + c0; na[q] = *(const u32x4*)up; nb[q] = *(const u32x4*)(up + DFF); }
#pragma unroll
                for (int tb = 0; tb < 4; ++tb) {
                    u32x4 ca[4], cbv[4];
#pragma unroll
                    for (int q = 0; q < 4; ++q) { ca[q] = na[q]; cbv[q] = nb[q]; }
                    if (tb < 3) {
#pragma unroll
                        for (int q = 0; q < 4; ++q) { const bf16_t* up = P + (size_t)(r0 + 4 * tb + 4 + q) * INW + C_UP + c0; na[q] = *(const u32x4*)up; nb[q] = *(const u32x4*)(up + DFF); }
                    }
#pragma unroll
                    for (int q = 0; q < 4; ++q) {
                        const u32x4 a4 = ca[q], b4 = cbv[q];
                        float cv_[8], cg_[8], hv[8];
#pragma unroll
                        for (int qq = 0; qq < 4; ++qq) { cv_[2 * qq] = __uint_as_float(a4[qq] << 16); cv_[2 * qq + 1] = __uint_as_float(a4[qq] & 0xffff0000u); cg_[2 * qq] = __uint_as_float(b4[qq] << 16); cg_[2 * qq + 1] = __uint_as_float(b4[qq] & 0xffff0000u); }
#pragma unroll
                        for (int e = 0; e < 8; ++e) {
                            const float val = bv_[e] + wv_[2][e] * cv_[e] + wv_[1][e] * pv[1][e] + wv_[0][e] * pv[0][e];
                            const float gt = bg_[e] + wg_[2][e] * cg_[e] + wg_[1][e] * pg[1][e] + wg_[0][e] * pg[0][e];
                            const float gl = gt * __builtin_amdgcn_rcpf(1.f + __expf(-1.5957691216057308f * (gt + 0.044715f * gt * gt * gt)));
                            hv[e] = gl * val;
                            pv[0][e] = pv[1][e]; pv[1][e] = cv_[e]; pg[0][e] = pg[1][e]; pg[1][e] = cg_[e];
                        }
                        u32x4 w; w.x = pk2(hv[0], hv[1]); w.y = pk2(hv[2], hv[3]); w.z = pk2(hv[4], hv[5]); w.w = pk2(hv[6], hv[7]);
                        *(u32x4*)(hp + (size_t)(4 * tb + q) * INW) = w;
                    }
                }
            }
        }
#ifndef CHAIN_DOWN
#define CHAIN_DOWN 1
#endif
        if (SUB && !CHAIN_DOWN) return;
        PM_SYNC();
        if constexpr (SUB) {
            constexpr int KS = 4, KSL = DFF / KS;
            pg8::Gemm g{c.HS, INW, c.WDN, KSL, -1, nullptr, DFF, (size_t)KSL * 2, (size_t)KSL * 2}; pg8::StaticOrder S; S.init(KS, 8, G, cb);
            EpiPart E{c.PART};
            pg8::gemm_phase<EpiPart, pg8::StaticOrder, true, true>(lds, g, S, E);
            PM_SYNC();
            { PM_TID(); for (int r = row_lo + gw; r < row_hi; r += NGW) {
                const float* md = c.MOD + (size_t)mod_row(r) * MODW;
                f32x4 f[8]; float s = 0.f;
#pragma unroll
                for (int j = 0; j < 8; ++j) {
                    const int cc = 4 * lane + 256 * j;
                    const float* pp = c.PART + (size_t)(r - row_lo) * DM + cc;
                    f[j] = (*(const f32x4*)pp + *(const f32x4*)(pp + (size_t)256 * DM)) + (*(const f32x4*)(pp + (size_t)512 * DM) + *(const f32x4*)(pp + (size_t)768 * DM));
                    s += (f[j].x * f[j].x + f[j].y * f[j].y) + (f[j].z * f[j].z + f[j].w * f[j].w);
                }
                const float rstd = rsqrtf(wave_sum(s) * (1.f / DM) + EPS);
#pragma unroll
                for (int j = 0; j < 8; ++j) {
                    const int cc = 4 * lane + 256 * j;
                    const f32x4 x1 = *(const f32x4*)(c.Y + (size_t)r * DM + cc), gp = *(const f32x4*)(c.g_post2 + cc), gt = *(const f32x4*)(md + MOD_GT2 + cc);
                    *(f32x4*)(c.Y + (size_t)r * DM + cc) = x1 + gt * (f[j] * rstd * gp);
                }
            } }
            return;
        }
        {
            const bool last = !CHAIN_DOWN && !SUB && hf == nparts - 1;
            pg8::Gemm g{h_row(c, prow_lo), INW, c.WDN, DFF, last ? nM : -1, c.HS}; pg8::StaticOrder S; S.init(last ? nM + 1 : nM, 8, G, cb);
            EpiSsq<false> E{P, C_F, c.SSQ, pm0};
            pg8::gemm_phase<EpiSsq<false>, pg8::StaticOrder, true, true>(lds, g, S, E);
        }
        PM_SYNC();
    }
    { PM_TID(); for (int r = row_lo + gw; r < (CHAIN_DOWN ? row_hi : MTOT); r += NGW) {
        const float* md = c.MOD + (size_t)mod_row(r) * MODW;
        const bf16_t* fr = P + (size_t)r * INW + C_F;
        const float q = lane < 32 ? c.SSQ[(size_t)r * 32 + lane] : 0.f;
        const float rstd = rsqrtf(wave_sum(q) * (1.f / DM) + EPS);
#pragma unroll
        for (int j = 0; j < 8; ++j) {
            const int cc = 4 * lane + 256 * j;
            const u32x2 fb = *(const u32x2*)(fr + cc);
            const f32x4 f = (f32x4){__uint_as_float(fb.x << 16), __uint_as_float(fb.x & 0xffff0000u), __uint_as_float(fb.y << 16), __uint_as_float(fb.y & 0xffff0000u)};
            const f32x4 x1 = *(const f32x4*)(c.Y + (size_t)r * DM + cc), gp = *(const f32x4*)(c.g_post2 + cc), gt = *(const f32x4*)(md + MOD_GT2 + cc);
            *(f32x4*)(c.Y + (size_t)r * DM + cc) = x1 + gt * (f * rstd * gp);
        }
    } }
#undef PM_SYNC
#undef PM_TID
}

__global__ void __launch_bounds__(512, 2) fwd_kernel(Args a) {
    extern __shared__ __attribute__((aligned(16))) unsigned char lds_raw[];
    LAS unsigned char* lds = (LAS unsigned char*)lds_raw;
    cg::grid_group grid = cg::this_grid();
    volatile LAS unsigned* bst = (volatile LAS unsigned*)(lds + LDS_BYTES - 64);
    if (threadIdx.x < 2) bst[threadIdx.x] = 0u;
    __syncthreads();
    const XcdBarrier xbar = xcd_barrier_post((unsigned*)(a.ws + WS_CTL) + 1024, bst);
    if (threadIdx.x == 0) bst[2] = atomicAdd((unsigned*)(a.ws + WS_CTL) + 256 + 16 * xbar.x, 1u);
#define GSYNC() xcd_barrier(xbar)
    const int G = gridDim.x, bid = blockIdx.x, NGW = G * 8;
#define PHASE_TID() int tid = threadIdx.x; asm volatile("" : "+v"(tid)); const int lane = tid & 63, wv = __builtin_amdgcn_readfirstlane(tid >> 6), gw = bid * 8 + wv; (void)lane; (void)gw
    const float *x_p = a.in[0], *x_s = a.in[1], *cache_k = a.in[2], *cache_v = a.in[3], *state_ret = a.in[4], *state_conv = a.in[5], *c_p = a.in[6], *c_s = a.in[7],
                *w_ada = a.in[8], *b_ada = a.in[9], *g_pre1 = a.in[10], *w_in = a.in[11], *rel_bias = a.in[12], *w_br_ret = a.in[13], *w_br_att = a.in[14], *w_out = a.in[15],
                *g_post1 = a.in[16], *g_pre2 = a.in[17], *w_up = a.in[18], *conv_w = a.in[19], *conv_b = a.in[20], *w_down = a.in[21], *g_post2 = a.in[22];
    float* out = a.out; unsigned char* ws = a.ws;
    unsigned* ctl = (unsigned*)(ws + WS_CTL);
    bf16_t *WIN = (bf16_t*)(ws + WS_WIN), *WUP = (bf16_t*)(ws + WS_WUP), *WDN = (bf16_t*)(ws + WS_WDN), *WBR = (bf16_t*)(ws + WS_WBR), *WBA = (bf16_t*)(ws + WS_WBA), *WOUT = (bf16_t*)(ws + WS_WOUT);
    float *MODP = (float*)(ws + WS_MODP), *MOD = (float*)(ws + WS_MOD), *SSQ = (float*)(ws + WS_SSQ);
    bf16_t *HS = (bf16_t*)(ws + WS_HS), *P = (bf16_t*)(ws + WS_PROJ);
    bf16_t* U = (bf16_t*)out;
    float* Y = out + OFF_Y;
    Ctx cx; cx.P = P; cx.HS = HS; cx.WBR = WBR; cx.WBA = WBA; cx.WOUT = WOUT; cx.WUP = WUP; cx.WDN = WDN; cx.out = out; cx.Y = Y; cx.SSQ = SSQ; cx.MOD = MOD;
    cx.x_p = x_p; cx.x_s = x_s; cx.g_post1 = g_post1; cx.g_pre2 = g_pre2; cx.g_post2 = g_post2; cx.conv_w = conv_w; cx.conv_b = conv_b; cx.state_conv = state_conv;
    cx.subbar = ctl + 64; cx.lds = lds; cx.xbar = xbar; cx.PART = MODP;

    if (PH(0)) {
        PHASE_TID();
        LAS float* scr = (LAS float*)(lds + wv * TR_BYTES);
        constexpr int I_IN = 64 * (INW / 128), I_UP = 64 * (UPW / 128), I_DN = (DFF / 32) * 16, I_BR = 64 * 16, I_BA = 32 * 16, I_OUT = 64 * 16, I_MOD = 16 * 48;
        constexpr int NIT = I_IN + I_UP + I_DN + I_BR + I_BA + I_OUT + I_MOD;
        for (int it = gw; it < NIT; it += NGW) {
            int r = it;
            if (r < I_MOD) { mod_item(c_p, c_s, w_ada, MODP, scr, r, lane); continue; } r -= I_MOD;
            if (r < I_IN) { transpose_item(w_in, DM, INW, WIN, scr, r, lane, true); continue; } r -= I_IN;
            if (r < I_UP) { transpose_item(w_up, DM, UPW, WUP, scr, r, lane, false); continue; } r -= I_UP;
            if (r < I_DN) { transpose_item(w_down, DFF, DM, WDN, scr, r, lane, false); continue; } r -= I_DN;
            if (r < I_BR) { transpose_item(w_br_ret, DM, DM, WBR, scr, r, lane, false); continue; } r -= I_BR;
            if (r < I_BA) { transpose_item(w_br_att, 1024, DM, WBA, scr, r, lane, false); continue; } r -= I_BA;
            transpose_item(w_out, DM, DM, WOUT, scr, r, lane, false);
        }
    }
    grid.sync();
    {
        if (threadIdx.x == 0) {
            const unsigned* xc = (const unsigned*)(a.ws + WS_CTL) + 256; const unsigned rk = bst[2]; unsigned v = 0;
            for (unsigned j = 0; j < 16; ++j) { const unsigned n = __hip_atomic_load(xc + 16 * j, __ATOMIC_RELAXED, __HIP_MEMORY_SCOPE_AGENT); v += n < rk ? n : rk; if (j < xbar.x && n > rk) ++v; }
            bst[3] = v;
        }
        __syncthreads();
    }
    const int vbid = (int)bst[3];
    if (PH(1)) { PHASE_TID(); for (int i = bid * 512 + tid; i < 24 * MODW / 4; i += G * 512) {
        const int r = i / (MODW / 4), c4 = (i % (MODW / 4)) * 4;
        f32x4 s = *(const f32x4*)(b_ada + c4);
#pragma unroll
        for (int sl = 0; sl < 16; ++sl) s += *(const f32x4*)(MODP + ((size_t)sl * 24 + r) * MODW + c4);
        *(f32x4*)(MOD + (size_t)r * MODW + c4) = s;
    } }
    GSYNC();
    if (PH(2)) { PHASE_TID(); for (int r = gw; r < MTOT; r += NGW) {
        const float* xr = r < MP ? x_p + (size_t)r * DM : x_s + (size_t)(r - MP) * DM;
        const float* md = MOD + (size_t)mod_row(r) * MODW;
        norm_mod_row(xr, g_pre1, md + MOD_SC1, md + MOD_SH1, U + (size_t)r * DM, lane);
    } }
    GSYNC();
    for (int rep1 = 0; rep1 < REP_P1; ++rep1) if (PH(3)) {
        pg8::Gemm g{U, DM, WIN, DM, -1, nullptr}; pg8::StaticOrder S; S.init(NTILE, INW / 256, G, vbid);
        EpiProj E{P, out};
        pg8::gemm_phase<EpiProj, pg8::StaticOrder, true, true>(lds, g, S, E);
    }
    GSYNC();
#ifdef DRY_P2
    {   PHASE_TID();
        LAS float* bl = (LAS float*)lds;
        for (int i = tid; i < 8 * 257; i += 512) bl[i] = rel_bias[i];
        __syncthreads();
        if (bid < 64) {
            ret_prompt_unit<true>(P, out, bid >> 3, bid & 7, lds, tid);
            __syncthreads();
            for (int i = tid; i < 8 * 257; i += 512) bl[i] = rel_bias[i];
            __syncthreads();
        }
        int tid_b = threadIdx.x; asm volatile("" : "+v"(tid_b)); const int lane_b = tid_b & 63;
        for (;;) {
            unsigned u = 0; if (lane_b == 0) u = atomicAdd(ctl + 1, 1u);
            u = (unsigned)__builtin_amdgcn_readfirstlane((int)u);
            if (u >= 8192u) break;
            att_unit<true>(P, (LAS float*)lds, (int)u, lane_b);
        }
    }
    GSYNC();
#endif
#ifdef DRY_ATT
    {   PHASE_TID();
        LAS float* bl = (LAS float*)lds;
        for (int i = tid; i < 8 * 257; i += 512) bl[i] = rel_bias[i];
        __syncthreads();
        for (;;) {
            unsigned u = 0; if (lane == 0) u = atomicAdd(ctl + 1, 1u);
            u = (unsigned)__builtin_amdgcn_readfirstlane((int)u);
            if (u >= 8192u) break;
            att_unit<true>(P, bl, (int)u, lane);
        }
    }
    GSYNC();
#endif
#ifdef DRY_RET
    {   PHASE_TID();
        if (bid < 64) ret_prompt_unit<true>(P, out, bid >> 3, bid & 7, lds, tid);
    }
    GSYNC();
#endif
    if (PH(4)) {
        PHASE_TID();
        LAS float* bl = (LAS float*)lds;
        for (int i = tid; i < 8 * 257; i += 512) bl[i] = rel_bias[i];
        __syncthreads();
        LAS unsigned char* scr = lds + 8448;
        constexpr int NSB = 44;
        {
            for (int u = bid; u < 256; u += G) {
                if (u < 128) { if (P2SUB & 2) ret_sample_unit(P, state_ret, out, u >> 3, u & 7, scr, tid); }
                else { if (P2SUB & 4) att_sample_unit(P, cache_k, cache_v, rel_bias, (u - 128) >> 3, (u - 128) & 7, scr, tid); }
            }
            asm volatile("s_waitcnt vmcnt(0)" ::: "memory");
            __syncthreads();
            if (tid == 0) { __builtin_amdgcn_fence(__ATOMIC_RELEASE, "agent"); asm volatile("s_waitcnt vmcnt(0)" ::: "memory"); (void)__hip_atomic_fetch_add(ctl + 128, 1u, __ATOMIC_RELAXED, __HIP_MEMORY_SCOPE_AGENT); }
        }
        if (bid < 64) { if (P2SUB & 1) ret_prompt_unit<false>(P, out, bid >> 3, bid & 7, lds, tid); }
        else {
            if (bid < 64 + NSB) {
                if (tid == 0) { unsigned sp = 0; while (__hip_atomic_load(ctl + 128, __ATOMIC_RELAXED, __HIP_MEMORY_SCOPE_AGENT) < (unsigned)G) { __builtin_amdgcn_s_sleep(2); if (++sp > (1u << 22)) break; }
                    __builtin_amdgcn_fence(__ATOMIC_ACQUIRE, "agent"); asm volatile("s_waitcnt vmcnt(0)" ::: "memory"); }
                __syncthreads();
                unsigned sg = 0;
                post_mixer<true>(cx, 128, 1, NSB, bid - 64, sg);
                __syncthreads();
                for (int i = tid; i < 8 * 257; i += 512) bl[i] = rel_bias[i];
                __syncthreads();
            }
        }
        int tid_b = threadIdx.x; asm volatile("" : "+v"(tid_b)); const int lane_b = tid_b & 63;
        for (unsigned kq = 0; kq < 8; ++kq) {
            const unsigned q = (xbar.x + kq) & 7u;
            for (;;) {
                unsigned u = 0; if (lane_b == 0) u = atomicAdd(ctl + 512 + 16 * q, 1u);
                u = (unsigned)__builtin_amdgcn_readfirstlane((int)u);
                if (u >= 1024u) break;
                if (P2SUB & 8) att_unit<false>(P, (LAS float*)lds, (int)(q * 1024u + u), lane_b);
            }
        }
    }
    GSYNC();
    {
        unsigned sg = 0;
        post_mixer<false>(cx, 0, 128, G, vbid, sg);
    }
}

extern "C" void kernel_launch(void* const* d_in, const int* in_sizes, int n_in, void* d_out, int out_size, void* d_ws, size_t ws_size, hipStream_t stream) {
    static int grid = 0;
    if (grid == 0) {
        if (n_in != 23 || ws_size < WS_END) { fprintf(stderr, "kernel_launch: unexpected inputs (n_in %d, ws %zu, need %zu)\n", n_in, ws_size, (size_t)WS_END); grid = -1; return; }
        int dev = 0, cus = 0, per_cu = 0;
        (void)hipGetDevice(&dev); (void)hipDeviceGetAttribute(&cus, hipDeviceAttributeMultiprocessorCount, dev);
        if (hipFuncSetAttribute((const void*)fwd_kernel, hipFuncAttributeMaxDynamicSharedMemorySize, LDS_BYTES) != hipSuccess) { fprintf(stderr, "kernel_launch: hipFuncSetAttribute failed\n"); grid = -1; return; }
        if (hipOccupancyMaxActiveBlocksPerMultiprocessor(&per_cu, (const void*)fwd_kernel, 512, LDS_BYTES) != hipSuccess || per_cu < 1) per_cu = 1;
        (void)hipGetLastError();
        grid = cus * 1;
        if (grid <= 0) grid = 256;
    }
    if (grid < 0) return;
    (void)hipMemsetAsync((char*)d_ws + WS_CTL, 0, 65536, stream);
    Args a{};
    for (int i = 0; i < 23; ++i) a.in[i] = (const float*)d_in[i];
    a.out = (float*)d_out; a.ws = (unsigned char*)d_ws;
    void* args[] = {&a};
    hipError_t e = hipLaunchCooperativeKernel((const void*)fwd_kernel, dim3(grid), dim3(512), args, LDS_BYTES, stream);
    if (e != hipSuccess) fprintf(stderr, "kernel_launch: cooperative launch failed: %s (grid %d)\n", hipGetErrorString(e), grid);
}
```

```cpp
#include <hip/hip_runtime.h>
#include <hip/hip_cooperative_groups.h>
#include <cstdio>
#include <cstdint>
namespace cg = cooperative_groups;
#define DI __device__ __forceinline__
namespace pg8 {
#define PG8_LAS __attribute__((address_space(3)))
typedef unsigned short bf16_t;
typedef short bf16x8 __attribute__((ext_vector_type(8)));
typedef float f32x4 __attribute__((ext_vector_type(4)));
typedef unsigned u32x4 __attribute__((ext_vector_type(4)));
typedef unsigned u32x2 __attribute__((ext_vector_type(2)));
constexpr int BM = 256, BK = 64, HALF = 128, HTB = HALF * BK * 2, STAGE_BYTES = 8 * HTB, NXCD = 8, WGM = 8;
__host__ __device__ __forceinline__ int lds_byte(int r, int c) { const int st = (r >> 4) * 2 + (c >> 5), rr = r & 15, cc = c & 31, ob = rr * 64 + cc * 2; return st * 1024 + (ob ^ (((ob >> 9) & 1) << 5)); }
__host__ __device__ __forceinline__ void stage_rc(int b, int& R, int& C) { const int st = b / 1024, sb = b % 1024, swz = sb ^ (((sb >> 9) & 1) << 5); R = (st >> 1) * 16 + swz / 64; C = (st & 1) * 32 + (swz % 64) / 2; }
__host__ __device__ __forceinline__ int perm32(int rho) { const int n = rho >> 4, i = rho & 15; return 8 * (i >> 2) + 4 * n + (i & 3); }
struct Unit { int pm, pn; };
struct Gemm { const bf16_t* A; int lda; const bf16_t* Bt; int K; int spm; const bf16_t* As; int ldb = 0; size_t a_tile_bytes = 0, b_pm_bytes = 0; };
__device__ __forceinline__ const char* tileA(const Gemm& g, int pm, size_t tstepA) { return pm == g.spm ? (const char*)g.As : (const char*)g.A + (size_t)pm * (g.a_tile_bytes ? g.a_tile_bytes : tstepA); }
struct StaticOrder {
    int nM, nN, nwg, G, c;
    __host__ __device__ void init(int nM_, int nN_, int G_, int c_) { nM = nM_; nN = nN_; nwg = nM * nN; G = G_; c = c_; }
    __host__ __device__ bool next(int i, Unit& u) const {
        const long L = (long)i * G + c; if (L >= nwg) return false;
        int wgid = (int)L; { const int q = nwg / NXCD, r = nwg % NXCD, xcd = wgid % NXCD, off = wgid / NXCD; wgid = (xcd < r ? xcd * (q + 1) : r * (q + 1) + (xcd - r) * q) + off; }
        const int nig = WGM * nN, gid = wgid / nig, fm = gid * WGM, gsz = (nM - fm) < WGM ? (nM - fm) : WGM;
        u.pm = fm + ((wgid % nig) % gsz); u.pn = (wgid % nig) / gsz; return true;
    }
    __device__ __forceinline__ void a_ready(const Unit&) const {}
    __device__ __forceinline__ void done(const Unit&) const {}
};
__device__ __forceinline__ unsigned cvt_pk_bf16(float lo, float hi) { unsigned r; asm volatile("v_cvt_pk_bf16_f32 %0, %1, %2" : "=v"(r) : "v"(lo), "v"(hi)); return r; }
template <class Epi, class Sched, bool ALIGN_EPI = false, bool SP2 = false>
__device__ __forceinline__ void gemm_phase(PG8_LAS unsigned char* lds, const Gemm g, const Sched& S, const Epi& E) {
    int tid_ = threadIdx.x; asm volatile("" : "+v"(tid_));
    const int tid = tid_, wid = __builtin_amdgcn_readfirstlane(tid >> 6), lane = tid & 63, wr = wid >> 2, wc = wid & 3, fr = lane & 15, fq = lane >> 4;
    const int K = g.K, nt = K / BK;
    unsigned voffA[2], voffB[2];
#pragma unroll
    for (int i = 0; i < 2; ++i) { int R, C; stage_rc(tid * 16 + i * 8192, R, C); const int Rb = Epi::PERM ? ((R & ~31) + perm32(R & 31)) : R;
        voffA[i] = (unsigned)(R * g.lda + C) * 2u; voffB[i] = (unsigned)(Rb * (g.ldb ? g.ldb : K) + C) * 2u; }
    const size_t kstep = (size_t)(BK * 2);
    const size_t hstepA = (size_t)HALF * g.lda * 2, hstepB = (size_t)HALF * (g.ldb ? g.ldb : K) * 2;
    const size_t tstepA = 2 * hstepA, tstepB = 2 * hstepB;
    const unsigned ldsw = (unsigned)wid * 1024u;
    const int aoff = lds_byte(wr * 64 + fr, fq * 8), boff = lds_byte(wc * 32 + fr, fq * 8);
#define PG8_SA(b, h) (((b) * 2 + (h)) * HTB)
#define PG8_SB(b, h) ((4 + (b) * 2 + (h)) * HTB)
#define PG8_STAGE(bufoff, gbase, voff) do { _Pragma("unroll") for (int _i = 0; _i < 2; ++_i) \
        __builtin_amdgcn_global_load_lds((const unsigned*)((const char*)(gbase) + (voff)[_i]), (PG8_LAS unsigned*)(lds + (bufoff) + ldsw + _i * 8192), 16, 0, 0); } while (0)
#define PG8_LDA(dst, b, h) do { _Pragma("unroll") for (int m = 0; m < 4; ++m) _Pragma("unroll") for (int k = 0; k < 2; ++k) dst[m][k] = *(const PG8_LAS bf16x8*)(lds + PG8_SA(b, h) + aoff + m * 2048 + k * 1024); } while (0)
#define PG8_LDB(dst, b, h) do { _Pragma("unroll") for (int n = 0; n < 2; ++n) _Pragma("unroll") for (int k = 0; k < 2; ++k) dst[n][k] = *(const PG8_LAS bf16x8*)(lds + PG8_SB(b, h) + boff + n * 2048 + k * 1024); } while (0)
#define PG8_MMA(ai, bj, At, Bt) do { __builtin_amdgcn_s_setprio(1); _Pragma("unroll") for (int m = 0; m < 4; ++m) _Pragma("unroll") for (int n = 0; n < 2; ++n) _Pragma("unroll") for (int k = 0; k < 2; ++k) \
        acc[ai][bj][m][n] = __builtin_amdgcn_mfma_f32_16x16x32_bf16(Bt[n][k], At[m][k], acc[ai][bj][m][n], 0, 0, 0); __builtin_amdgcn_s_setprio(0); } while (0)
#define PG8_WAIT_V(n) asm volatile("s_waitcnt vmcnt(" #n ")" ::: "memory")
#define PG8_WAIT_L(n) asm volatile("s_waitcnt lgkmcnt(" #n ")" ::: "memory")
#define PG8_BAR __builtin_amdgcn_s_barrier()
#define PG8_SCHED __builtin_amdgcn_sched_barrier(0)
    Unit cur, nxt; int ui = 0;
    if (!S.next(0, cur)) return;
    f32x4 acc[2][2][4][2];
#pragma unroll
    for (int a = 0; a < 2; ++a)
#pragma unroll
        for (int b = 0; b < 2; ++b)
#pragma unroll
            for (int m = 0; m < 4; ++m)
#pragma unroll
                for (int n = 0; n < 2; ++n) acc[a][b][m][n] = (f32x4){0.f, 0.f, 0.f, 0.f};
    bf16x8 At[4][2], B0[2][2], B1[2][2];
    const char* cA = tileA(g, cur.pm, tstepA); const char* cB = (const char*)g.Bt + (size_t)cur.pn * tstepB + (size_t)cur.pm * g.b_pm_bytes;
    S.a_ready(cur);
    if constexpr (SP2) {
        PG8_STAGE(PG8_SB(0, 0), cB, voffB); PG8_STAGE(PG8_SB(0, 1), cB + hstepB, voffB); PG8_STAGE(PG8_SA(0, 0), cA, voffA); PG8_STAGE(PG8_SA(0, 1), cA + hstepA, voffA);
        if (wr == 1) PG8_BAR;
        PG8_WAIT_V(2); PG8_BAR;
        PG8_STAGE(PG8_SB(1, 0), cB + kstep, voffB); PG8_STAGE(PG8_SA(1, 0), cA + kstep, voffA); PG8_STAGE(PG8_SB(1, 1), cB + hstepB + kstep, voffB);
        PG8_WAIT_V(6); PG8_BAR;
    } else {
        PG8_STAGE(PG8_SB(0, 0), cB, voffB); PG8_STAGE(PG8_SA(0, 0), cA, voffA); PG8_STAGE(PG8_SB(0, 1), cB + hstepB, voffB); PG8_STAGE(PG8_SA(0, 1), cA + hstepA, voffA);
        if (wr == 1) PG8_BAR;
        PG8_WAIT_V(4); PG8_BAR;
        PG8_STAGE(PG8_SB(1, 0), cB + kstep, voffB); PG8_STAGE(PG8_SA(1, 0), cA + kstep, voffA); PG8_STAGE(PG8_SB(1, 1), cB + hstepB + kstep, voffB);
        PG8_WAIT_V(6); PG8_BAR;
    }
    for (;;) {
        const bool has_next = S.next(ui + 1, nxt);
        const char* nA = has_next ? tileA(g, nxt.pm, tstepA) : cA; const char* nB = has_next ? (const char*)g.Bt + (size_t)nxt.pn * tstepB + (size_t)nxt.pm * g.b_pm_bytes : cB;
        for (int t = 0; t < nt; t += 2) {
            const bool last = (t == nt - 2);
            const char* a1 = cA + (size_t)(t + 1) * kstep;
            const char* a2 = last ? nA : cA + (size_t)(t + 2) * kstep; const char* b2 = last ? nB : cB + (size_t)(t + 2) * kstep;
            const char* a3 = a2 + kstep; const char* b3 = b2 + kstep;
            if (last && has_next) S.a_ready(nxt);
            if constexpr (SP2) {
            PG8_LDB(B0, 0, 0); PG8_LDB(B1, 0, 1); PG8_SCHED; PG8_LDA(At, 0, 0); PG8_STAGE(PG8_SA(1, 1), a1 + hstepA, voffA);
            PG8_WAIT_V(8); PG8_WAIT_L(0); PG8_BAR; PG8_MMA(0, 0, At, B0); PG8_MMA(0, 1, At, B1); PG8_BAR; PG8_SCHED;
            PG8_LDA(At, 0, 1); PG8_STAGE(PG8_SB(0, 0), b2, voffB); PG8_STAGE(PG8_SB(0, 1), b2 + hstepB, voffB); PG8_STAGE(PG8_SA(0, 0), a2, voffA);
            PG8_WAIT_V(8); PG8_WAIT_L(0); PG8_BAR; PG8_MMA(1, 0, At, B0); PG8_MMA(1, 1, At, B1); PG8_BAR; PG8_SCHED;
            PG8_LDB(B0, 1, 0); PG8_LDB(B1, 1, 1); PG8_SCHED; PG8_LDA(At, 1, 0); PG8_STAGE(PG8_SA(0, 1), a2 + hstepA, voffA);
            PG8_WAIT_V(8); PG8_WAIT_L(0); PG8_BAR; PG8_MMA(0, 0, At, B0); PG8_MMA(0, 1, At, B1); PG8_BAR; PG8_SCHED;
            PG8_LDA(At, 1, 1); PG8_STAGE(PG8_SB(1, 0), b3, voffB); PG8_STAGE(PG8_SB(1, 1), b3 + hstepB, voffB); PG8_STAGE(PG8_SA(1, 0), a3, voffA);
            PG8_WAIT_V(8); PG8_WAIT_L(0); PG8_BAR; PG8_MMA(1, 0, At, B0); PG8_MMA(1, 1, At, B1); PG8_BAR; PG8_SCHED;
            } else {
            PG8_LDB(B0, 0, 0); PG8_SCHED; PG8_LDA(At, 0, 0); PG8_STAGE(PG8_SA(1, 1), a1 + hstepA, voffA);
            PG8_WAIT_L(8); PG8_BAR; PG8_WAIT_L(0); PG8_MMA(0, 0, At, B0); PG8_BAR; PG8_SCHED;
            PG8_LDB(B1, 0, 1); PG8_STAGE(PG8_SB(0, 0), b2, voffB);
            PG8_BAR; PG8_WAIT_L(0); PG8_MMA(0, 1, At, B1); PG8_BAR;
            PG8_LDA(At, 0, 1); PG8_STAGE(PG8_SA(0, 0), a2, voffA);
            PG8_BAR; PG8_WAIT_L(0); PG8_MMA(1, 0, At, B0); PG8_BAR; PG8_SCHED;
            PG8_STAGE(PG8_SB(0, 1), b2 + hstepB, voffB);
            PG8_WAIT_V(6); PG8_BAR; PG8_MMA(1, 1, At, B1); PG8_BAR;
            PG8_LDB(B0, 1, 0); PG8_SCHED; PG8_LDA(At, 1, 0); PG8_STAGE(PG8_SA(0, 1), a2 + hstepA, voffA);
            PG8_WAIT_L(8); PG8_BAR; PG8_WAIT_L(0); PG8_MMA(0, 0, At, B0); PG8_BAR; PG8_SCHED;
            PG8_LDB(B1, 1, 1); PG8_STAGE(PG8_SB(1, 0), b3, voffB);
            PG8_BAR; PG8_WAIT_L(0); PG8_MMA(0, 1, At, B1); PG8_BAR;
            PG8_LDA(At, 1, 1); PG8_STAGE(PG8_SA(1, 0), a3, voffA);
            PG8_BAR; PG8_WAIT_L(0); PG8_MMA(1, 0, At, B0); PG8_BAR; PG8_SCHED;
            PG8_STAGE(PG8_SB(1, 1), b3 + hstepB, voffB);
            PG8_WAIT_V(6); PG8_BAR; PG8_MMA(1, 1, At, B1); PG8_BAR;
            }
        }
        if constexpr (ALIGN_EPI) { if (wr == 0) PG8_BAR; }
        if constexpr (!Epi::AFTER_DRAIN) { E(acc, cur, wr, wc, fr, fq); if constexpr (Epi::TWICE) { asm volatile("" ::: "memory"); E(acc, cur, wr, wc, fr, fq); } S.done(cur); }
        if (!has_next) break;
#pragma unroll
        for (int a = 0; a < 2; ++a)
#pragma unroll
            for (int b = 0; b < 2; ++b)
#pragma unroll
                for (int m = 0; m < 4; ++m)
#pragma unroll
                    for (int n = 0; n < 2; ++n) acc[a][b][m][n] = (f32x4){0.f, 0.f, 0.f, 0.f};
        cur = nxt; cA = nA; cB = nB; ++ui;
        if constexpr (ALIGN_EPI) { if (wr == 1) PG8_BAR; }
    }
    PG8_WAIT_V(0);
    if constexpr (!ALIGN_EPI) { if (wr == 0) PG8_BAR; }
    PG8_BAR;
    if constexpr (Epi::AFTER_DRAIN) { E.fused(acc, cur, wr, wc, fr, fq, lds, wid, lane); S.done(cur); }
#undef PG8_SA
#undef PG8_SB
#undef PG8_STAGE
#undef PG8_LDA
#undef PG8_LDB
#undef PG8_MMA
#undef PG8_WAIT_V
#undef PG8_WAIT_L
#undef PG8_BAR
#undef PG8_SCHED
}
}

using pg8::bf16_t; using pg8::bf16x8; using pg8::f32x4; using pg8::u32x4; using pg8::u32x2; using pg8::Unit;
typedef float f32x16 __attribute__((ext_vector_type(16)));
#define LAS __attribute__((address_space(3)))
constexpr int DM = 2048, SEQ = 4096, NBATCH = 8, MP = NBATCH * SEQ, MS = 256, MTOT = MP + MS, NTILE = MTOT / 256;
constexpr int INW = 13312, DFF = 5632, UPW = 2 * DFF;
constexpr int C_RQ = 0, C_RK = 1024, C_RV = 2048, C_RG = 4096, C_AQ = 6144, C_AK = 7168, C_AV = 8192, C_GR = 9216, C_GA = 11264;
constexpr int C_U2 = 0, C_UP = 2048, C_H = 2048, C_F = 2048 + DFF;
constexpr float EPS = 1e-6f;
constexpr size_t OFF_Y = 0, OFF_KP = (size_t)MTOT * DM, OFF_VP = OFF_KP + 4194304, OFF_RP = OFF_VP + 4194304, OFF_CP = OFF_RP + 2097152,
                 OFF_KS = OFF_CP + 180224, OFF_VS = OFF_KS + 262144, OFF_RS = OFF_VS + 262144, OFF_CS = OFF_RS + 4194304;
constexpr size_t MiB = 1u << 20;
constexpr size_t WS_CTL = 0, WS_WIN = 1 * MiB, WS_WUP = 53 * MiB, WS_WDN = 97 * MiB, WS_WBR = 119 * MiB, WS_WBA = 127 * MiB, WS_WOUT = 131 * MiB,
                 WS_MODP = 139 * MiB, WS_MOD = 157 * MiB, WS_SSQ = 159 * MiB, WS_HS = 164 * MiB, WS_PROJ = 171 * MiB, WS_END = WS_PROJ + (size_t)MTOT * INW * 2;
static_assert(WS_END <= 1024 * MiB, "ws map");
constexpr int LDS_BYTES = 147456;
constexpr int MOD_SH1 = 0, MOD_SC1 = 2048, MOD_GT1 = 4096, MOD_SH2 = 6144, MOD_SC2 = 8192, MOD_GT2 = 10240, MODW = 12288;

DI float bf2f(unsigned short v) { return __uint_as_float((unsigned)v << 16); }
typedef __bf16 hwbf2 __attribute__((ext_vector_type(2)));
typedef float hwf2 __attribute__((ext_vector_type(2)));
DI unsigned pk2(float lo, float hi) { hwf2 v = {lo, hi}; return __builtin_bit_cast(unsigned, __builtin_convertvector(v, hwbf2)); }
DI unsigned f2bf(float f) { return pk2(f, f) & 0xffffu; }
DI float wave_sum(float v) {
#pragma unroll
    for (int o = 1; o < 64; o <<= 1) v += __shfl_xor(v, o);
    return v;
}
DI float sigmoidf_(float x) { return __builtin_amdgcn_rcpf(1.f + __expf(-x)); }
DI int crow(int reg, int h) { return (reg & 3) + 8 * (reg >> 2) + 4 * h; }
#define MFMA32(a, b, c) __builtin_amdgcn_mfma_f32_32x32x16_bf16((a), (b), (c), 0, 0, 0)
DI bf16x8 pack_step(const f32x16& x, int s) {
    u32x4 p;
    p[0] = pk2(x[8 * s + 0], x[8 * s + 1]); p[1] = pk2(x[8 * s + 2], x[8 * s + 3]); p[2] = pk2(x[8 * s + 4], x[8 * s + 5]); p[3] = pk2(x[8 * s + 6], x[8 * s + 7]);
    return __builtin_bit_cast(bf16x8, p);
}
DI int mod_row(int r) { return r < MP ? (r >> 12) : 8 + ((r - MP) >> 4); }

#ifndef PHMASK
#define PHMASK 0xffff
#endif
#define PH(k) ((PHMASK >> (k)) & 1)
#ifndef REP_P0
#define REP_P0 1
#endif
#ifndef REP_P1
#define REP_P1 1
#endif
#ifndef REP_FFN
#define REP_FFN 1
#endif
#ifndef P2SUB
#define P2SUB 15
#endif
struct Args { const float* in[23]; float* out; unsigned char* ws; };

#ifndef EPI_TWICE_PROJ
#define EPI_TWICE_PROJ false
#endif
struct EpiProj {
    static constexpr bool PERM = true, AFTER_DRAIN = false, TWICE = EPI_TWICE_PROJ;
    bf16_t* P; float* out;
    DI void operator()(const f32x4 (&acc)[2][2][4][2], const Unit& u, int wr, int wc, int fr, int fq) const {
        const int pn = u.pn, pm = u.pm;
        const int rbase = pm * 256 + wr * 64 + fr;
        if (pn < 8) {
            const float scale = pn >= 4 ? 0.08838834764831845f : 1.f;
            const int i0 = 16 * wc + 4 * fq;
            float inv[4];
#pragma unroll
            for (int e = 0; e < 4; ++e) inv[e] = exp2f(-(float)(i0 + e) * (13.287712379549449f / 64.f));
#pragma unroll
            for (int ai = 0; ai < 2; ++ai)
#pragma unroll
                for (int m = 0; m < 4; ++m) {
                    const int r = rbase + ai * 128 + m * 16;
                    const float pos = (float)(r < MP ? (r & 4095) : 4096 + (r & 15));
                    float cs[4], sn[4];
#pragma unroll
                    for (int e = 0; e < 4; ++e) { float rev = (pos * inv[e]) * 0.15915494309189535f; rev -= floorf(rev); sn[e] = __builtin_amdgcn_sinf(rev); cs[e] = __builtin_amdgcn_cosf(rev); }
                    bf16_t* rowp = P + (size_t)r * INW + pn * 256;
#pragma unroll
                    for (int bj = 0; bj < 2; ++bj) {
                        const f32x4 x1 = acc[ai][bj][m][0], x2 = acc[ai][bj][m][1];
                        float o1[4], o2[4];
#pragma unroll
                        for (int e = 0; e < 4; ++e) { o1[e] = (x1[e] * cs[e] - x2[e] * sn[e]) * scale; o2[e] = (x1[e] * sn[e] + x2[e] * cs[e]) * scale; }
                        u32x2 w1, w2; w1.x = pk2(o1[0], o1[1]); w1.y = pk2(o1[2], o1[3]); w2.x = pk2(o2[0], o2[1]); w2.y = pk2(o2[2], o2[3]);
                        *(u32x2*)(rowp + bj * 128 + i0) = w1; *(u32x2*)(rowp + bj * 128 + 64 + i0) = w2;
                    }
                }
            return;
        }
        const bool isv = (pn >= 8 && pn < 16) || (pn >= 32 && pn < 36);
        if (isv && pm < 128) {
            const int hh = (fr >> 2) & 1, j = ((fr >> 3) << 2) | (fr & 3);
#pragma unroll
            for (int ai = 0; ai < 2; ++ai)
#pragma unroll
                for (int m = 0; m < 4; ++m) {
                    const int rowblk = pm * 256 + ai * 128 + wr * 64 + m * 16;
#pragma unroll
                    for (int bj = 0; bj < 2; ++bj)
#pragma unroll
                        for (int n = 0; n < 2; ++n) {
                            bf16_t* p;
                            if (pn >= 32) { const int bb = (pn - 32) * 8 + bj * 4 + wc;
                                p = P + (size_t)(rowblk + (bb >> 1)) * INW + C_AV + (bb & 1) * 512 + (hh * 32 + 8 * fq + 4 * n) * 8 + j; }
                            else p = P + (size_t)(rowblk + hh * 8 + 2 * fq + n) * INW + pn * 256 + bj * 128 + wc * 32 + j;
                            const f32x4 v = acc[ai][bj][m][n];
#pragma unroll
                            for (int e = 0; e < 4; ++e) p[8 * e] = (bf16_t)f2bf(v[e]);
                        }
                }
        } else if (pn >= 28 && pn < 32 && pm < 128) {
            const int ks = 2 * wc + (fq >> 1), khh = fq & 1;
#pragma unroll
            for (int ai = 0; ai < 2; ++ai)
#pragma unroll
                for (int m = 0; m < 4; ++m) {
                    const int r = rbase + ai * 128 + m * 16;
#pragma unroll
                    for (int bj = 0; bj < 2; ++bj) {
                        const int blk = ((pn - 28) * 2 + bj) * 8 + ks;
                        const f32x4 v0 = acc[ai][bj][m][0], v1 = acc[ai][bj][m][1];
                        u32x4 w; w.x = pk2(v0[0], v0[1]); w.y = pk2(v0[2], v0[3]); w.z = pk2(v1[0], v1[1]); w.w = pk2(v1[2], v1[3]);
                        *(u32x4*)(P + (size_t)((r & ~31) + (blk >> 1)) * INW + C_AK + (blk & 1) * 512 + ((r & 31) + 32 * khh) * 8) = w;
                    }
                }
        } else {
            const int act = (pn >= 16 && pn < 24) ? 1 : (pn >= 36 ? 2 : 0);
            const float sc = (pn >= 24 && pn < 28) ? 0.08838834764831845f : 1.f;
#pragma unroll
            for (int ai = 0; ai < 2; ++ai)
#pragma unroll
                for (int m = 0; m < 4; ++m) {
                    bf16_t* rowp = P + (size_t)(rbase + ai * 128 + m * 16) * INW + pn * 256 + wc * 32 + 8 * fq;
#pragma unroll
                    for (int bj = 0; bj < 2; ++bj) {
                        f32x4 v0 = acc[ai][bj][m][0] * sc, v1 = acc[ai][bj][m][1] * sc;
                        if (act) {
#pragma unroll
                            for (int e = 0; e < 4; ++e) { const float s0 = sigmoidf_(v0[e]), s1 = sigmoidf_(v1[e]); v0[e] = act == 1 ? v0[e] * s0 : s0; v1[e] = act == 1 ? v1[e] * s1 : s1; }
                        }
                        u32x4 w; w.x = pk2(v0[0], v0[1]); w.y = pk2(v0[2], v0[3]); w.z = pk2(v1[0], v1[1]); w.w = pk2(v1[2], v1[3]);
                        *(u32x4*)(rowp + bj * 128) = w;
                    }
                }
        }
        const bool isk = pn >= 28 && pn < 32, isav = pn >= 32 && pn < 36;
        if ((isk || isav) && (pm == 128 || (pm & 15) >= 14)) {
            float* ob; size_t rowidx0;
            if (pm == 128) { ob = out + (isk ? OFF_KS : OFF_VS); rowidx0 = 0; }
            else { ob = out + (isk ? OFF_KP : OFF_VP); rowidx0 = (size_t)(pm >> 4) * 512 + ((pm & 15) - 14) * 256; }
            const int cseg = (pn - (isk ? 28 : 32)) * 256 + wc * 32 + 8 * fq;
#pragma unroll
            for (int ai = 0; ai < 2; ++ai)
#pragma unroll
                for (int m = 0; m < 4; ++m) {
                    float* rowp = ob + (rowidx0 + ai * 128 + wr * 64 + m * 16 + fr) * 1024 + cseg;
#pragma unroll
                    for (int bj = 0; bj < 2; ++bj) { *(f32x4*)(rowp + bj * 128) = acc[ai][bj][m][0]; *(f32x4*)(rowp + bj * 128 + 4) = acc[ai][bj][m][1]; }
                }
        }
    }
};
template <int MODE> struct EpiMerge {
    static constexpr bool PERM = true, AFTER_DRAIN = false, TWICE = false;
    bf16_t* P; int pm0;
    DI void operator()(const f32x4 (&acc)[2][2][4][2], const Unit& u, int wr, int wc, int fr, int fq) const {
        const int rbase = (u.pm + pm0) * 256 + wr * 64 + fr, cb = u.pn * 256 + wc * 32 + 8 * fq;
#pragma unroll
        for (int ai = 0; ai < 2; ++ai) {
            u32x4 tv[4][2], gv[4][2];
#pragma unroll
            for (int m = 0; m < 4; ++m) {
                const bf16_t* rowp = P + (size_t)(rbase + ai * 128 + m * 16) * INW + cb;
#pragma unroll
                for (int bj = 0; bj < 2; ++bj) { tv[m][bj] = *(const u32x4*)(rowp + C_GR + bj * 128); if (MODE == 1) gv[m][bj] = *(const u32x4*)(rowp + C_GA + bj * 128); else gv[m][bj] = tv[m][bj]; }
            }
#pragma unroll
            for (int m = 0; m < 4; ++m) {
                bf16_t* rowp = P + (size_t)(rbase + ai * 128 + m * 16) * INW + cb;
#pragma unroll
                for (int bj = 0; bj < 2; ++bj) {
                    const u32x4 t = tv[m][bj], g = gv[m][bj];
                    const f32x4 a0 = acc[ai][bj][m][0], a1 = acc[ai][bj][m][1];
                    float o[8];
#pragma unroll
                    for (int q = 0; q < 4; ++q) {
                        const float glo = __uint_as_float(g[q] << 16), ghi = __uint_as_float(g[q] & 0xffff0000u);
                        const float alo = q < 2 ? a0[2 * q] : a1[2 * q - 4], ahi = q < 2 ? a0[2 * q + 1] : a1[2 * q - 3];
                        float lo = glo * alo, hi = ghi * ahi;
                        if (MODE == 1) { lo += __uint_as_float(t[q] << 16); hi += __uint_as_float(t[q] & 0xffff0000u); }
                        o[2 * q] = lo; o[2 * q + 1] = hi;
                    }
                    u32x4 w; w.x = pk2(o[0], o[1]); w.y = pk2(o[2], o[3]); w.z = pk2(o[4], o[5]); w.w = pk2(o[6], o[7]);
                    *(u32x4*)(rowp + C_GR + bj * 128) = w;
                }
            }
        }
    }
};
template <bool F32OUT> struct EpiSsq {
    static constexpr bool PERM = true, AFTER_DRAIN = false, TWICE = false;
    bf16_t* P; int ccol; float* ssq; int pm0;
    DI void operator()(const f32x4 (&acc)[2][2][4][2], const Unit& u, int wr, int wc, int fr, int fq) const {
        const int rbase = (u.pm + pm0) * 256 + wr * 64 + fr, cb = u.pn * 256 + wc * 32 + 8 * fq;
#pragma unroll
        for (int ai = 0; ai < 2; ++ai)
#pragma unroll
            for (int m = 0; m < 4; ++m) {
                const int r = rbase + ai * 128 + m * 16;
                float s = 0.f;
#pragma unroll
                for (int bj = 0; bj < 2; ++bj) {
                    const f32x4 v0 = acc[ai][bj][m][0], v1 = acc[ai][bj][m][1];
                    s += (v0[0] * v0[0] + v0[1] * v0[1]) + (v0[2] * v0[2] + v0[3] * v0[3]) + (v1[0] * v1[0] + v1[1] * v1[1]) + (v1[2] * v1[2] + v1[3] * v1[3]);
                    if (F32OUT) { float* rowp = (float*)(P + (size_t)r * INW) + cb + bj * 128; *(f32x4*)rowp = v0; *(f32x4*)(rowp + 4) = v1; }
                    else { u32x4 w; w.x = pk2(v0[0], v0[1]); w.y = pk2(v0[2], v0[3]); w.z = pk2(v1[0], v1[1]); w.w = pk2(v1[2], v1[3]); *(u32x4*)(P + (size_t)r * INW + ccol + cb + bj * 128) = w; }
                }
                s += __shfl_xor(s, 16); s += __shfl_xor(s, 32);
                if (fq == 0) ssq[(size_t)r * 32 + u.pn * 4 + wc] = s;
            }
    }
};
struct EpiPart {
    static constexpr bool PERM = true, AFTER_DRAIN = false, TWICE = false;
    float* part;
    DI void operator()(const f32x4 (&acc)[2][2][4][2], const Unit& u, int wr, int wc, int fr, int fq) const {
        float* base = part + ((size_t)u.pm * 256 + wr * 64 + fr) * DM + u.pn * 256 + wc * 32 + 8 * fq;
#pragma unroll
        for (int ai = 0; ai < 2; ++ai)
#pragma unroll
            for (int m = 0; m < 4; ++m) {
                float* rowp = base + (size_t)(ai * 128 + m * 16) * DM;
#pragma unroll
                for (int bj = 0; bj < 2; ++bj) { *(f32x4*)(rowp + bj * 128) = acc[ai][bj][m][0]; *(f32x4*)(rowp + bj * 128 + 4) = acc[ai][bj][m][1]; }
            }
    }
};
#ifndef EPI_TWICE_UP
#define EPI_TWICE_UP false
#endif
struct EpiUp {
    static constexpr bool PERM = true, AFTER_DRAIN = false, TWICE = EPI_TWICE_UP;
    bf16_t* P; float* out; int pm0;
    DI void operator()(const f32x4 (&acc)[2][2][4][2], const Unit& u, int wr, int wc, int fr, int fq) const {
        const int rbase = (u.pm + pm0) * 256 + wr * 64 + fr, cb = u.pn * 256 + wc * 32 + 8 * fq;
#pragma unroll
        for (int ai = 0; ai < 2; ++ai)
#pragma unroll
            for (int m = 0; m < 4; ++m) {
                const int r = rbase + ai * 128 + m * 16;
                float* cst = nullptr;
                if (r < MP) { const int t = r & 4095; if (t >= 4094) cst = out + OFF_CP + ((size_t)(r >> 12) * 2 + (t - 4094)) * UPW; }
                else { const int t = r & 15; if (t >= 14) cst = out + OFF_CS + ((size_t)((r - MP) >> 4) * 2 + (t - 14)) * UPW; }
#pragma unroll
                for (int bj = 0; bj < 2; ++bj) {
                    const f32x4 v0 = acc[ai][bj][m][0], v1 = acc[ai][bj][m][1];
                    u32x4 w; w.x = pk2(v0[0], v0[1]); w.y = pk2(v0[2], v0[3]); w.z = pk2(v1[0], v1[1]); w.w = pk2(v1[2], v1[3]);
                    *(u32x4*)(P + (size_t)r * INW + C_UP + cb + bj * 128) = w;
                    if (cst) { *(f32x4*)(cst + cb + bj * 128) = v0; *(f32x4*)(cst + cb + bj * 128 + 4) = v1; }
                }
            }
    }
};

constexpr int TR_RS = 132, TR_BYTES = 32 * TR_RS * 4;
DI void transpose_item(const float* W, int K, int N, bf16_t* WT, LAS float* scr, int item, int lane, bool permq) {
    const int nblk = N / 128, kb = item / nblk, nb = item % nblk, k0 = 32 * kb, n0 = 128 * nb;
    const int c = lane & 31, kh = lane >> 5;
    const int pc = (permq && n0 < 2048) ? (32 * ((c >> 2) & 3) + 8 * (c & 3) + 4 * (c >> 4)) : 4 * c;
    const float* src = W + (size_t)(k0 + kh) * N + n0 + 4 * c;
    f32x4 v[16];
#pragma unroll
    for (int i = 0; i < 16; ++i) v[i] = *(const f32x4*)(src + (size_t)(2 * i) * N);
#pragma unroll
    for (int i = 0; i < 16; ++i) *(LAS f32x4*)(scr + (2 * i + kh) * TR_RS + pc) = v[i];
    asm volatile("s_waitcnt lgkmcnt(0)" ::: "memory");
    const int kc = lane & 3;
#pragma unroll
    for (int jj = 0; jj < 8; ++jj) { const int n = (lane >> 2) + 16 * jj; const LAS float* s = scr + (8 * kc) * TR_RS + n;
        u32x4 o; o.x = pk2(s[0 * TR_RS], s[1 * TR_RS]); o.y = pk2(s[2 * TR_RS], s[3 * TR_RS]); o.z = pk2(s[4 * TR_RS], s[5 * TR_RS]); o.w = pk2(s[6 * TR_RS], s[7 * TR_RS]);
        *(u32x4*)(WT + (size_t)(n0 + n) * K + k0 + 8 * kc) = o; }
    asm volatile("s_waitcnt lgkmcnt(0)" ::: "memory");
}
DI void mod_item(const float* cp, const float* cs, const float* wada, float* modp, LAS float* scr, int item, int lane) {
    const int s = item / 48, cb = item % 48, k0 = s * 128;
    for (int i = lane; i < 24 * 128; i += 64) { const int r = i >> 7, k = i & 127; const float c = r < 8 ? cp[r * DM + k0 + k] : cs[(r - 8) * DM + k0 + k]; scr[i] = c * sigmoidf_(c); }
    asm volatile("s_waitcnt lgkmcnt(0)" ::: "memory");
    f32x4 acc[24];
#pragma unroll
    for (int r = 0; r < 24; ++r) acc[r] = (f32x4){0.f, 0.f, 0.f, 0.f};
    const float* wp = wada + (size_t)k0 * MODW + cb * 256 + lane * 4;
    for (int k = 0; k < 128; k += 16) {
        f32x4 w[16];
#pragma unroll
        for (int i = 0; i < 16; ++i) w[i] = *(const f32x4*)(wp + (size_t)(k + i) * MODW);
#pragma unroll
        for (int r = 0; r < 24; ++r) {
#pragma unroll
            for (int i4 = 0; i4 < 4; ++i4) { const f32x4 c4 = *(const LAS f32x4*)(scr + r * 128 + k + 4 * i4); acc[r] += w[4 * i4] * c4.x + w[4 * i4 + 1] * c4.y + w[4 * i4 + 2] * c4.z + w[4 * i4 + 3] * c4.w; }
        }
    }
#pragma unroll
    for (int r = 0; r < 24; ++r) *(f32x4*)(modp + ((size_t)s * 24 + r) * MODW + cb * 256 + lane * 4) = acc[r];
    asm volatile("s_waitcnt lgkmcnt(0)" ::: "memory");
}
DI void norm_mod_row(const float* xrow, const float* g, const float* sc, const float* sh, bf16_t* orow, int lane) {
    f32x4 v[8]; float s = 0.f;
#pragma unroll
    for (int j = 0; j < 8; ++j) { v[j] = *(const f32x4*)(xrow + 4 * lane + 256 * j); s += (v[j].x * v[j].x + v[j].y * v[j].y) + (v[j].z * v[j].z + v[j].w * v[j].w); }
    const float rstd = rsqrtf(wave_sum(s) * (1.f / DM) + EPS);
#pragma unroll
    for (int j = 0; j < 8; ++j) {
        const int c = 4 * lane + 256 * j;
        const f32x4 gg = *(const f32x4*)(g + c), a = *(const f32x4*)(sc + c), b = *(const f32x4*)(sh + c);
        const f32x4 o = (v[j] * rstd) * gg * (a + 1.f) + b;
        u32x2 w; w.x = pk2(o.x, o.y); w.y = pk2(o.z, o.w); *(u32x2*)(orow + c) = w;
    }
}

template <bool DRY> DI void att_unit(bf16_t* P, const LAS float* bl, int unit, int lane) {
    asm volatile("" : "+v"(lane));
    const int qh = unit & 1, c = (unit >> 1) & 63, h = (unit >> 7) & 7, b = unit >> 10;
    bl += h * 257;
    const int r32 = lane & 31, hh = lane >> 5;
    const size_t rowb = (size_t)b * SEQ;
    const int t0 = c * 64 + qh * 32, qpos = t0 + r32;
    const bf16_t* qrow = P + (rowb + t0 + r32) * INW + C_AQ + 128 * h + 8 * hh;
    bf16x8 qf[8];
#pragma unroll
    for (int ks = 0; ks < 8; ++ks) qf[ks] = *(const bf16x8*)(qrow + 16 * ks);
    f32x16 o[4];
#pragma unroll
    for (int d = 0; d < 4; ++d)
#pragma unroll
        for (int i = 0; i < 16; ++i) o[d][i] = 0.f;
    float mrun = -1e30f, lrun = 0.f;
    const int k0 = c * 64 - 512 < 0 ? 0 : c * 64 - 512, k1 = c * 64 + 64;
    bf16x8 kf[8];
    {
#pragma unroll
        for (int ks = 0; ks < 8; ++ks) kf[ks] = *(const bf16x8*)(P + (rowb + k0 + ((h * 8 + ks) >> 1)) * INW + C_AK + ((h * 8 + ks) & 1) * 512 + lane * 8); }
    bf16x8 vf[2][4];
#pragma unroll
    for (int s2 = 0; s2 < 2; ++s2)
#pragma unroll
        for (int d = 0; d < 4; ++d) vf[s2][d] = *(const bf16x8*)(P + (rowb + k0 + 16 * s2 + ((h * 4 + d) >> 1)) * INW + C_AV + ((h * 4 + d) & 1) * 512 + lane * 8);
    for (int key0 = k0; key0 < k1; key0 += 32) {
        f32x16 s;
#pragma unroll
        for (int i = 0; i < 16; ++i) s[i] = 0.f;
#pragma unroll
        for (int ks = 0; ks < 8; ++ks) s = MFMA32(kf[ks], qf[ks], s);
        {
            const int kn0 = key0 + 32 < k1 ? key0 + 32 : key0;
#pragma unroll
            for (int ks = 0; ks < 8; ++ks) kf[ks] = *(const bf16x8*)(P + (rowb + kn0 + ((h * 8 + ks) >> 1)) * INW + C_AK + ((h * 8 + ks) & 1) * 512 + lane * 8); }
        float mx = -1e30f;
        if (key0 + 159 <= t0) {
            const float b0 = bl[0];
#pragma unroll
            for (int i = 0; i < 16; ++i) { s[i] += b0; mx = fmaxf(mx, s[i]); }
        } else {
#pragma unroll
            for (int i = 0; i < 16; ++i) { int idx = key0 + crow(i, hh) - qpos + 128; idx = idx < 0 ? 0 : idx; s[i] += bl[idx]; mx = fmaxf(mx, s[i]); }
        }
        mx = fmaxf(mx, __shfl_xor(mx, 32));
        if (__builtin_amdgcn_ballot_w64(mx - mrun > 8.f) != 0ull) {
            const float mnew = fmaxf(mrun, mx), alpha = __expf(mrun - mnew);
            lrun *= alpha; mrun = mnew;
#pragma unroll
            for (int d = 0; d < 4; ++d)
#pragma unroll
                for (int i = 0; i < 16; ++i) o[d][i] *= alpha;
        }
        float psum = 0.f;
#pragma unroll
        for (int i = 0; i < 16; ++i) { const float p = __expf(s[i] - mrun); psum += p; s[i] = p; }
        lrun += psum;
#pragma unroll
        for (int s2 = 0; s2 < 2; ++s2) {
            const bf16x8 xs = pack_step(s, s2);
#pragma unroll
            for (int d = 0; d < 4; ++d) o[d] = MFMA32(vf[s2][d], xs, o[d]);
        }
        {
            const int kn0 = key0 + 32 < k1 ? key0 + 32 : key0;
#pragma unroll
            for (int s2 = 0; s2 < 2; ++s2)
#pragma unroll
                for (int d = 0; d < 4; ++d) vf[s2][d] = *(const bf16x8*)(P + (rowb + kn0 + 16 * s2 + ((h * 4 + d) >> 1)) * INW + C_AV + ((h * 4 + d) & 1) * 512 + lane * 8);
        }
    }
    const float inv = 1.f / (lrun + __shfl_xor(lrun, 32));
    bf16_t* orow = P + (rowb + t0 + r32) * INW + C_AQ + 128 * h + 4 * hh;
    if (!DRY || lrun < -1.f)
#pragma unroll
    for (int d = 0; d < 4; ++d)
#pragma unroll
        for (int g = 0; g < 4; ++g) { u32x2 w; w.x = pk2(o[d][4 * g] * inv, o[d][4 * g + 1] * inv); w.y = pk2(o[d][4 * g + 2] * inv, o[d][4 * g + 3] * inv); *(u32x2*)(orow + 32 * d + 8 * g) = w; }
}

constexpr int RT_RS = 272, RT_QLB = 64 * RT_RS, RT_BUFB = 2 * RT_QLB + 16384, RT_ORS = 528, RT_LDS0 = 8448;
DI void ret_stage_qk(LAS unsigned char* buf, const u32x4 (&qn)[2], const u32x4 (&kn)[2], int tid, float lg) {
#pragma unroll
    for (int it = 0; it < 2; ++it) {
        const int piece = tid + 512 * it, m = piece >> 4, ch = piece & 15;
        *(LAS u32x4*)(buf + m * RT_RS + ch * 16) = qn[it];
        *(LAS u32x4*)(buf + RT_QLB + m * RT_RS + ch * 16) = kn[it];
        const float dk = __builtin_amdgcn_exp2f((float)(63 - m) * lg);
        const int m16 = m >> 4, t4 = m & 15, khh = (t4 >> 2) & 1, j = ((t4 >> 3) << 2) | (t4 & 3), db = ch >> 2, dl0 = (ch & 3) * 8;
        LAS bf16_t* dst = (LAS bf16_t*)(buf + 2 * RT_QLB) + ((((m16 * 4 + db) * 2 + khh) * 32 + dl0) * 8 + j);
#pragma unroll
        for (int q = 0; q < 4; ++q) {
            dst[(2 * q) * 8] = (bf16_t)f2bf(__uint_as_float(kn[it][q] << 16) * dk);
            dst[(2 * q + 1) * 8] = (bf16_t)f2bf(__uint_as_float(kn[it][q] & 0xffff0000u) * dk);
        }
    }
}
template <bool DRY> DI void ret_prompt_unit(bf16_t* P, float* out, int b, int h, LAS unsigned char* lds0, int tid) {
    asm volatile("" : "+v"(tid));
    LAS unsigned char* lds = lds0 + RT_LDS0;
    LAS unsigned char* XA = lds + 2 * RT_BUFB;
    const int w = __builtin_amdgcn_readfirstlane(tid >> 6);
    const float lg = log2f(1.f - exp2f(-5.f - (float)h));
    const float dsc = __builtin_amdgcn_exp2f(64.f * lg), g1 = __builtin_amdgcn_exp2f(lg), g8 = __builtin_amdgcn_exp2f(8.f * lg);
    f32x16 S[4];
#pragma unroll
    for (int d = 0; d < 4; ++d)
#pragma unroll
        for (int i = 0; i < 16; ++i) S[d][i] = 0.f;
    bf16x8 vf[4];
    {
        const size_t R0 = (size_t)b * SEQ;
        const int lane = tid & 63, r32 = lane & 31, hh = lane >> 5;
        u32x4 qn[2], kn[2];
#pragma unroll
        for (int it = 0; it < 2; ++it) { const int piece = tid + 512 * it, m = piece >> 4, ch = piece & 15;
            qn[it] = *(const u32x4*)(P + (R0 + m) * INW + C_RQ + 128 * h + 8 * ch); kn[it] = *(const u32x4*)(P + (R0 + m) * INW + C_RK + 128 * h + 8 * ch); }
#pragma unroll
        for (int m16 = 0; m16 < 4; ++m16) vf[m16] = *(const bf16x8*)(P + (R0 + 16 * m16 + hh * 8 + (r32 >> 2)) * INW + C_RV + 256 * h + 32 * w + (r32 & 3) * 8);
        __syncthreads();
        ret_stage_qk(lds, qn, kn, tid, lg);
        __syncthreads();
    }
    for (int c = 0; c < 64; ++c) {
        asm volatile("" : "+v"(tid));
        const int lane = tid & 63, r32 = lane & 31, hh = lane >> 5;
        const size_t R0 = (size_t)b * SEQ + 64 * c, R1 = R0 + 64;
        LAS unsigned char* cur = lds + (c & 1) * RT_BUFB; LAS unsigned char* nxt = lds + ((c & 1) ^ 1) * RT_BUFB;
        const LAS unsigned char* QL = cur; const LAS unsigned char* KL = cur + RT_QLB; const LAS bf16_t* KD = (const LAS bf16_t*)(cur + 2 * RT_QLB);
        {
            const int tr = w >> 1, tc0 = 2 * (w & 1), i16 = lane & 15, kq = lane >> 4;
            f32x4 xt[2] = {(f32x4){0.f, 0.f, 0.f, 0.f}, (f32x4){0.f, 0.f, 0.f, 0.f}};
            const LAS unsigned char* kp = KL + (16 * tr + i16) * RT_RS + 16 * kq;
            const LAS unsigned char* qp0 = QL + (16 * tc0 + i16) * RT_RS + 16 * kq;
#pragma unroll
            for (int ks = 0; ks < 4; ++ks) {
                const bf16x8 kf = *(const LAS bf16x8*)(kp + 64 * ks);
#pragma unroll
                for (int tt = 0; tt < 2; ++tt) { const bf16x8 qf = *(const LAS bf16x8*)(qp0 + tt * 16 * RT_RS + 64 * ks); xt[tt] = __builtin_amdgcn_mfma_f32_16x16x32_bf16(kf, qf, xt[tt], 0, 0, 0); }
            }
#pragma unroll
            for (int tt = 0; tt < 2; ++tt) {
                const int tc = tc0 + tt; const float nm = (float)((16 * tc + i16) - (16 * tr + 4 * kq));
                float xv[4];
#pragma unroll
                for (int e = 0; e < 4; ++e) xv[e] = xt[tt][e] * __builtin_amdgcn_exp2f(fabsf(nm - (float)e) * lg);
                u32x2 pk; pk.x = pk2(xv[0], xv[1]); pk.y = pk2(xv[2], xv[3]);
                *(LAS u32x2*)(XA + (((tc >> 1) * 4 + tr) * 64 + ((tc & 1) * 16 + i16) + 32 * (kq & 1)) * 16 + (kq >> 1) * 8) = pk;
            }
        }
        f32x16 O[2];
#pragma unroll
        for (int nb = 0; nb < 2; ++nb)
#pragma unroll
            for (int i = 0; i < 16; ++i) O[nb][i] = 0.f;
#pragma unroll
        for (int db = 0; db < 4; ++db)
#pragma unroll
            for (int s = 0; s < 2; ++s) {
                const bf16x8 xs = pack_step(S[db], s);
#pragma unroll
                for (int nb = 0; nb < 2; ++nb) {
                    const LAS unsigned char* qp = QL + (32 * nb + r32) * RT_RS + (32 * db + 16 * s + 4 * hh) * 2;
                    const u32x2 lo = *(const LAS u32x2*)qp, hi = *(const LAS u32x2*)(qp + 16);
                    u32x4 pq; pq.x = lo.x; pq.y = lo.y; pq.z = hi.x; pq.w = hi.y;
                    O[nb] = MFMA32(__builtin_bit_cast(bf16x8, pq), xs, O[nb]);
                }
                if (s == 1) asm volatile("" ::: "memory");
            }
        {
            float fg = __builtin_amdgcn_exp2f((float)(4 * hh + 1) * lg);
#pragma unroll
            for (int nb = 0; nb < 2; ++nb)
#pragma unroll
                for (int g = 0; g < 4; ++g) {
                    float fe = fg;
#pragma unroll
                    for (int e = 0; e < 4; ++e) { O[nb][4 * g + e] *= fe; fe *= g1; }
                    fg *= g8;
                }
        }
        u32x4 qn[2], kn[2];
#pragma unroll
        for (int it = 0; it < 2; ++it) { const int piece = tid + 512 * it, m = piece >> 4, ch = piece & 15;
            qn[it] = *(const u32x4*)(P + (R1 + m) * INW + C_RQ + 128 * h + 8 * ch); kn[it] = *(const u32x4*)(P + (R1 + m) * INW + C_RK + 128 * h + 8 * ch); }
        __syncthreads();
#pragma unroll
        for (int nb = 0; nb < 2; ++nb)
#pragma unroll
            for (int m16 = 0; m16 < 4; ++m16) { const bf16x8 xa = *(const LAS bf16x8*)(XA + ((nb * 4 + m16) * 64 + lane) * 16); O[nb] = MFMA32(xa, vf[m16], O[nb]); }
#pragma unroll
        for (int db = 0; db < 4; ++db) {
#pragma unroll
            for (int i = 0; i < 16; ++i) S[db][i] *= dsc;
#pragma unroll
            for (int m16 = 0; m16 < 4; ++m16) { const bf16x8 kd = *(const LAS bf16x8*)(KD + ((m16 * 4 + db) * 64 + lane) * 8); S[db] = MFMA32(kd, vf[m16], S[db]); }
        }
        asm volatile("" ::: "memory");
#pragma unroll
        for (int m16 = 0; m16 < 4; ++m16) vf[m16] = *(const bf16x8*)(P + (R1 + 16 * m16 + hh * 8 + (r32 >> 2)) * INW + C_RV + 256 * h + 32 * w + (r32 & 3) * 8);
        const int on = tid >> 3, oseg = tid & 7;
        bf16_t* orow = P + (R0 + on) * INW + 256 * h + 32 * oseg;
        u32x4 gr[4];
#pragma unroll
        for (int j = 0; j < 4; ++j) gr[j] = *(const u32x4*)(orow + C_RG + 8 * j);
        __syncthreads();
        LAS bf16_t* olb = (LAS bf16_t*)(cur + (4 * hh) * RT_ORS) + 32 * w + r32;
#pragma unroll
        for (int nb = 0; nb < 2; ++nb)
#pragma unroll
            for (int i = 0; i < 16; ++i) {
                constexpr int dummy = 0; (void)dummy;
                const int cn = 32 * nb + (i & 3) + 8 * (i >> 2);
                olb[cn * (RT_ORS / 2)] = (bf16_t)f2bf(O[nb][i]);
            }
        ret_stage_qk(nxt, qn, kn, tid, lg);
        __syncthreads();
        {
            u32x4 ovs[4]; float sq = 0.f;
#pragma unroll
            for (int j = 0; j < 4; ++j) { ovs[j] = *(const LAS u32x4*)(cur + on * RT_ORS + oseg * 64 + j * 16);
#pragma unroll
                for (int q = 0; q < 4; ++q) { const float lo = __uint_as_float(ovs[j][q] << 16), hi = __uint_as_float(ovs[j][q] & 0xffff0000u); sq += lo * lo + hi * hi; } }
            sq += __shfl_xor(sq, 1); sq += __shfl_xor(sq, 2); sq += __shfl_xor(sq, 4);
            const float rstd = rsqrtf(sq * (1.f / 256.f) + EPS);
#pragma unroll
            for (int j = 0; j < 4; ++j) {
                const u32x4 ov = ovs[j];
                u32x4 wv4;
#pragma unroll
                for (int q = 0; q < 4; ++q) {
                    const float lo = __uint_as_float(ov[q] << 16) * rstd * __uint_as_float(gr[j][q] << 16);
                    const float hi = __uint_as_float(ov[q] & 0xffff0000u) * rstd * __uint_as_float(gr[j][q] & 0xffff0000u);
                    wv4[q] = pk2(lo, hi);
                }
                if (!DRY || dsc < 0.f) *(u32x4*)(orow + C_RV + 8 * j) = wv4;
            }
        }
    }
    const int lane = tid & 63, r32 = lane & 31, hh = lane >> 5;
    float* so = out + OFF_RP + ((size_t)(b * 8 + h) * 128) * 256 + 32 * w + r32;
#pragma unroll
    for (int db = 0; db < 4; ++db)
#pragma unroll
        for (int i = 0; i < 16; ++i) if (!DRY || dsc < 0.f) so[(size_t)(32 * db + crow(i, hh)) * 256] = S[db][i];
    __syncthreads();
}

DI void ret_sample_unit(bf16_t* P, const float* state_in, float* out, int sb, int h, LAS unsigned char* lds, int tid) {
    asm volatile("" : "+v"(tid));
    LAS float* qs = (LAS float*)lds; LAS float* ks = qs + 2048; LAS float* vs = ks + 2048; LAS float* As = vs + 4096; LAS float* part = As + 256;
    const size_t R0 = (size_t)MP + 16 * sb;
    const float lg = log2f(1.f - exp2f(-5.f - (float)h));
    __syncthreads();
    for (int i = tid; i < 2048; i += 512) { const int t = i >> 7, d = i & 127; qs[i] = bf2f(P[(R0 + t) * INW + C_RQ + 128 * h + d]); ks[i] = bf2f(P[(R0 + t) * INW + C_RK + 128 * h + d]); }
    for (int i = tid; i < 4096; i += 512) { const int t = i >> 8, e = i & 255; vs[i] = bf2f(P[(R0 + t) * INW + C_RV + 256 * h + e]); }
    __syncthreads();
    if (tid < 256) { const int n = tid >> 4, m = tid & 15; float a = 0.f;
#pragma unroll 4
        for (int d = 0; d < 128; ++d) a += qs[n * 128 + d] * ks[m * 128 + d]; const int dd = n > m ? n - m : m - n; As[tid] = a * exp2f((float)dd * lg); }
    __syncthreads();
    const int e = tid & 255, hf = tid >> 8;
    const float* S0 = state_in + ((size_t)(sb * 8 + h) * 128) * 256 + e;
    float o[8];
#pragma unroll
    for (int i = 0; i < 8; ++i) o[i] = 0.f;
    {
        float vd[16];
#pragma unroll
        for (int m = 0; m < 16; ++m) vd[m] = vs[m * 256 + e] * exp2f((float)(15 - m) * lg);
        const float d16 = exp2f(16.f * lg); float* so = out + OFF_RS + ((size_t)(sb * 8 + h) * 128) * 256 + e;
#pragma unroll 1
        for (int d0 = 0; d0 < 128; d0 += 4) {
            float s4[4];
#pragma unroll
            for (int i = 0; i < 4; ++i) s4[i] = S0[(size_t)(d0 + i) * 256];
#pragma unroll
            for (int n = 0; n < 8; ++n) { const f32x4 q4 = *(const LAS f32x4*)(qs + (8 * hf + n) * 128 + d0); o[n] += (q4.x * s4[0] + q4.y * s4[1]) + (q4.z * s4[2] + q4.w * s4[3]); }
            if ((d0 >> 6) == hf) {
                float av[4];
#pragma unroll
                for (int i = 0; i < 4; ++i) av[i] = d16 * s4[i];
#pragma unroll
                for (int m = 0; m < 16; ++m) { const f32x4 k4 = *(const LAS f32x4*)(ks + m * 128 + d0); av[0] += k4.x * vd[m]; av[1] += k4.y * vd[m]; av[2] += k4.z * vd[m]; av[3] += k4.w * vd[m]; }
#pragma unroll
                for (int i = 0; i < 4; ++i) so[(size_t)(d0 + i) * 256] = av[i];
            }
        }
    }
    {
        float vreg[16];
#pragma unroll
        for (int m = 0; m < 16; ++m) vreg[m] = vs[m * 256 + e];
#pragma unroll
        for (int i = 0; i < 8; ++i) { const int n = 8 * hf + i; float a = o[i] * exp2f((float)(n + 1) * lg);
#pragma unroll
            for (int m = 0; m < 16; ++m) a += As[n * 16 + m] * vreg[m];
            o[i] = a; }
    }
    const int wv = tid >> 6, lane = tid & 63;
#pragma unroll
    for (int i = 0; i < 8; ++i) { const float q = wave_sum(o[i] * o[i]); if (lane == 0) part[(8 * hf + i) * 4 + (wv & 3)] = q; }
    __syncthreads();
#pragma unroll
    for (int i = 0; i < 8; ++i) { const int n = 8 * hf + i; const float rstd = rsqrtf(((part[n * 4] + part[n * 4 + 1]) + (part[n * 4 + 2] + part[n * 4 + 3])) * (1.f / 256.f) + EPS);
        bf16_t* rp = P + (R0 + n) * INW + 256 * h + e; rp[C_RV] = (bf16_t)f2bf(o[i] * rstd * bf2f(rp[C_RG])); }
    __syncthreads();
}
DI void att_sample_unit(bf16_t* P, const float* ck, const float* cv, const float* relb, int sb, int h, LAS unsigned char* lds, int tid) {
    asm volatile("" : "+v"(tid));
    LAS float* qs = (LAS float*)lds; LAS float* sc = qs + 2048;
    const size_t R0 = (size_t)MP + 16 * sb;
    __syncthreads();
    for (int i = tid; i < 2048; i += 512) { const int t = i >> 7, d = i & 127; qs[i] = bf2f(P[(R0 + t) * INW + C_AQ + 128 * h + d]); }
    __syncthreads();
    for (int key = tid; key < 528; key += 512) {
        float acc[16];
#pragma unroll
        for (int q = 0; q < 16; ++q) acc[q] = 0.f;
        if (key < 512) {
            const float* kr = ck + (((size_t)sb * 512 + key) * 8 + h) * 128;
            for (int d = 0; d < 128; d += 4) { const f32x4 kv = *(const f32x4*)(kr + d);
#pragma unroll
                for (int q = 0; q < 16; ++q) { const f32x4 qq = *(const LAS f32x4*)(qs + q * 128 + d); acc[q] += (kv.x * qq.x + kv.y * qq.y) + (kv.z * qq.z + kv.w * qq.w); } }
        } else {
            const bf16_t* kr = P + (R0 + key - 512) * INW + C_AK + 128 * h;
            for (int d = 0; d < 128; ++d) { const float kv = bf2f(kr[d]);
#pragma unroll
                for (int q = 0; q < 16; ++q) acc[q] += kv * qs[q * 128 + d]; }
        }
        const int kpos = key < 512 ? 3584 + key : 4096 + (key - 512);
#pragma unroll
        for (int q = 0; q < 16; ++q) { int rel = kpos - (4096 + q); rel = rel < -128 ? -128 : (rel > 128 ? 128 : rel); sc[q * 528 + key] = acc[q] + relb[h * 257 + rel + 128]; }
    }
    __syncthreads();
    { const int wv = tid >> 6, lane = tid & 63;
      for (int q = 2 * wv; q < 2 * wv + 2; ++q) {
          float mx = -1e30f; for (int k = lane; k < 528; k += 64) mx = fmaxf(mx, sc[q * 528 + k]);
#pragma unroll
          for (int o = 1; o < 64; o <<= 1) mx = fmaxf(mx, __shfl_xor(mx, o));
          float sm = 0.f; for (int k = lane; k < 528; k += 64) { const float p = __expf(sc[q * 528 + k] - mx); sc[q * 528 + k] = p; sm += p; }
          sm = wave_sum(sm); const float inv = 1.f / sm;
          for (int k = lane; k < 528; k += 64) sc[q * 528 + k] *= inv;
      } }
    __syncthreads();
    { const int d4 = (tid & 31) * 4, q = tid >> 5;
      f32x4 a = (f32x4){0.f, 0.f, 0.f, 0.f};
      const float* vr = cv + ((size_t)sb * 512 * 8 + h) * 128 + d4;
#pragma unroll 1
      for (int k0 = 0; k0 < 512; k0 += 8) {
          f32x4 vv[8];
#pragma unroll
          for (int i = 0; i < 8; ++i) vv[i] = *(const f32x4*)(vr + (size_t)(k0 + i) * 1024);
          const f32x4 p0 = *(const LAS f32x4*)(sc + q * 528 + k0), p1 = *(const LAS f32x4*)(sc + q * 528 + k0 + 4);
          a += (vv[0] * p0.x + vv[1] * p0.y) + (vv[2] * p0.z + vv[3] * p0.w) + (vv[4] * p1.x + vv[5] * p1.y) + (vv[6] * p1.z + vv[7] * p1.w);
      }
      for (int k = 0; k < 16; ++k) { const bf16_t* vp = P + (R0 + k) * INW + C_AV + 128 * h + d4; const float p = sc[q * 528 + 512 + k];
          a.x += bf2f(vp[0]) * p; a.y += bf2f(vp[1]) * p; a.z += bf2f(vp[2]) * p; a.w += bf2f(vp[3]) * p; }
      u32x2 w; w.x = pk2(a.x, a.y); w.y = pk2(a.z, a.w);
      *(u32x2*)(P + (R0 + q) * INW + C_AQ + 128 * h + d4) = w; }
    __syncthreads();
}

#define XB_TMO      128
#define XB_XCNT(j)  (256  + 64 * (j))
#define XB_XSUB(j)  (1280 + 64 * (j))
#define XB_XGEN(j)  (2304 + 64 * (j))
#define XB_TOP      3328
#define XB_TOPGEN   3392
#define XCD_BAR_WORDS 3456
#define XB_SPIN_CAP (1u << 18)

__device__ __forceinline__ unsigned xb_ld(unsigned* p)              { return __hip_atomic_load(p, __ATOMIC_RELAXED, __HIP_MEMORY_SCOPE_AGENT); }
__device__ __forceinline__ unsigned xb_add(unsigned* p, unsigned v) { return __hip_atomic_fetch_add(p, v, __ATOMIC_RELAXED, __HIP_MEMORY_SCOPE_AGENT); }
__device__ __forceinline__ unsigned xb_xcc_id() { return (unsigned)__builtin_amdgcn_s_getreg((3 << 11) | 20) & 0xFu; }
#define XB_SPIN(cond, bar) do { unsigned _sp = 0; while (cond) { __builtin_amdgcn_s_sleep(1); \
    if ((++_sp & 255u) == 0u) { if (xb_ld(&(bar)[XB_TMO])) break; if (_sp > XB_SPIN_CAP) { atomicAdd(&(bar)[XB_TMO], 1u); break; } } } } while (0)

struct XcdBarrier {
    unsigned* bar; unsigned x;
    volatile LAS unsigned* st;
};

__device__ __forceinline__ XcdBarrier xcd_barrier_post(unsigned* bar, volatile LAS unsigned* st) {
    XcdBarrier b; b.bar = bar; b.x = xb_xcc_id(); b.st = st;
    if (threadIdx.x == 0) (void)xb_add(&bar[XB_XCNT(b.x)], 1u);
    return b;
}
__device__ __forceinline__ void xcd_barrier_complete(unsigned* bar, unsigned x, unsigned& nloc, unsigned& nx) {
    const unsigned G = gridDim.x * gridDim.y * gridDim.z;
    unsigned sum, cnt, mine, sp = 0u;
    for (;;) {
        sum = 0u; cnt = 0u; mine = 0u;
#pragma unroll
        for (unsigned j = 0; j < 16; ++j) { const unsigned c = xb_ld(&bar[XB_XCNT(j)]); sum += c; cnt += (c > 0u) ? 1u : 0u; mine = (j == x) ? c : mine; }
        if (sum == G) break;
        __builtin_amdgcn_s_sleep(1);
        if ((++sp & 255u) == 0u) { if (xb_ld(&bar[XB_TMO])) break; if (sp > XB_SPIN_CAP) { atomicAdd(&bar[XB_TMO], 1u); break; } }
    }
    nloc = mine > 0u ? mine : 1u; nx = cnt > 0u ? cnt : 1u;
}

__device__ __forceinline__ void xcd_barrier(const XcdBarrier& b) {
    asm volatile("s_waitcnt vmcnt(0)" ::: "memory");
    __syncthreads();
    if (threadIdx.x == 0) {
        unsigned* bar = b.bar;
        __builtin_amdgcn_s_waitcnt(0);
        unsigned nloc = b.st[0], nx = b.st[1];
        if (nloc == 0u) { xcd_barrier_complete(bar, b.x, nloc, nx); b.st[0] = nloc; b.st[1] = nx; }
        const unsigned old = xb_add(&bar[XB_XSUB(b.x)], 1u);
        const unsigned gen = old / nloc;
        if (old + 1u == (gen + 1u) * nloc) {
            __builtin_amdgcn_fence(__ATOMIC_RELEASE, "agent");
            asm volatile("s_waitcnt vmcnt(0)" ::: "memory");
            const unsigned og = xb_add(&bar[XB_TOP], 1u);
            const unsigned tg = og / nx;
            if (og + 1u == (tg + 1u) * nx) xb_add(&bar[XB_TOPGEN], 1u);
            else XB_SPIN(xb_ld(&bar[XB_TOPGEN]) == tg, bar);
            __builtin_amdgcn_fence(__ATOMIC_ACQUIRE, "agent");
            xb_add(&bar[XB_XGEN(b.x)], 1u);
            asm volatile("s_waitcnt vmcnt(0)" ::: "memory");
        } else {
            XB_SPIN(xb_ld(&bar[XB_XGEN(b.x)]) == gen, bar);
            __builtin_amdgcn_fence(__ATOMIC_ACQUIRE, "agent");
            asm volatile("s_waitcnt vmcnt(0)" ::: "memory");
        }
    }
    __syncthreads();
}


struct Ctx { bf16_t *P, *HS, *WBR, *WBA, *WOUT, *WUP, *WDN; float *out, *Y, *SSQ, *MOD, *PART; const float *x_p, *x_s, *g_post1, *g_pre2, *g_post2, *conv_w, *conv_b, *state_conv; unsigned* subbar; LAS unsigned char* lds; XcdBarrier xbar; };
DI void sub_barrier(unsigned* cnt, unsigned nblk, unsigned& gen) {
    asm volatile("s_waitcnt vmcnt(0)" ::: "memory");
    __syncthreads();
    ++gen;
    if (threadIdx.x == 0) {
        __builtin_amdgcn_fence(__ATOMIC_RELEASE, "agent");
        asm volatile("s_waitcnt vmcnt(0)" ::: "memory");
        (void)__hip_atomic_fetch_add(cnt, 1u, __ATOMIC_RELAXED, __HIP_MEMORY_SCOPE_AGENT);
        const unsigned want = gen * nblk; unsigned sp = 0;
        while (__hip_atomic_load(cnt, __ATOMIC_RELAXED, __HIP_MEMORY_SCOPE_AGENT) < want) { __builtin_amdgcn_s_sleep(2); if (++sp > (1u << 22)) break; }
        __builtin_amdgcn_fence(__ATOMIC_ACQUIRE, "agent");
        asm volatile("s_waitcnt vmcnt(0)" ::: "memory");
    }
    __syncthreads();
}
DI bf16_t* h_row(const Ctx& c, int r) { return r < 16384 ? c.P + (size_t)(r + 16384) * INW + C_H : (r < 32768 ? c.P + (size_t)(r - 16384) * INW + C_H : c.HS + (size_t)(r - 32768) * INW); }
template <bool SUB> DI void post_mixer(const Ctx& c, int tile_lo, int ntile, int G, int cb, unsigned& sgen) {
#define PM_SYNC() do { if (SUB) sub_barrier(c.subbar, (unsigned)G, sgen); else xcd_barrier(c.xbar); } while (0)
#define PM_TID() int tid = threadIdx.x; asm volatile("" : "+v"(tid)); const int lane = tid & 63, wv = __builtin_amdgcn_readfirstlane(tid >> 6), gw = cb * 8 + wv; (void)lane; (void)gw
    bf16_t* P = c.P; LAS unsigned char* lds = c.lds;
    const int NGW = G * 8, row_lo = tile_lo * 256, row_hi = row_lo + ntile * 256;
    {
        pg8::Gemm g{P + (size_t)row_lo * INW + C_RV, INW, c.WBR, DM, -1, nullptr}; pg8::StaticOrder S; S.init(ntile, 8, G, cb);
        EpiMerge<0> E{P, tile_lo};
        pg8::gemm_phase<EpiMerge<0>, pg8::StaticOrder, true, true>(lds, g, S, E);
    }
    {
        pg8::Gemm g{P + (size_t)row_lo * INW + C_AQ, INW, c.WBA, 1024, -1, nullptr}; pg8::StaticOrder S; S.init(ntile, 8, G, cb);
        EpiMerge<1> E{P, tile_lo};
        pg8::gemm_phase<EpiMerge<1>, pg8::StaticOrder, true, true>(lds, g, S, E);
    }
    PM_SYNC();
    {
        pg8::Gemm g{P + (size_t)row_lo * INW + C_GR, INW, c.WOUT, DM, -1, nullptr}; pg8::StaticOrder S; S.init(ntile, 8, G, cb);
        EpiSsq<false> E{P, 0, c.SSQ, tile_lo};
        pg8::gemm_phase<EpiSsq<false>, pg8::StaticOrder, true, true>(lds, g, S, E);
    }
    PM_SYNC();
    { PM_TID(); for (int r = row_lo + gw; r < row_hi; r += NGW) {
        const float* xr = r < MP ? c.x_p + (size_t)r * DM : c.x_s + (size_t)(r - MP) * DM;
        const float* md = c.MOD + (size_t)mod_row(r) * MODW;
        const bf16_t* zr = P + (size_t)r * INW;
        const float q = lane < 32 ? c.SSQ[(size_t)r * 32 + lane] : 0.f;
        const float rstd1 = rsqrtf(wave_sum(q) * (1.f / DM) + EPS);
        f32x4 v[8]; float s = 0.f;
#pragma unroll
        for (int j = 0; j < 8; ++j) {
            const int cc = 4 * lane + 256 * j;
            const u32x2 zb = *(const u32x2*)(zr + cc);
            const f32x4 z = (f32x4){__uint_as_float(zb.x << 16), __uint_as_float(zb.x & 0xffff0000u), __uint_as_float(zb.y << 16), __uint_as_float(zb.y & 0xffff0000u)};
            const f32x4 xx = *(const f32x4*)(xr + cc), gp = *(const f32x4*)(c.g_post1 + cc), gt = *(const f32x4*)(md + MOD_GT1 + cc);
            v[j] = xx + gt * (z * rstd1 * gp);
            *(f32x4*)(c.Y + (size_t)r * DM + cc) = v[j];
            s += (v[j].x * v[j].x + v[j].y * v[j].y) + (v[j].z * v[j].z + v[j].w * v[j].w);
        }
        const float rstd2 = rsqrtf(wave_sum(s) * (1.f / DM) + EPS);
        bf16_t* orow = P + (size_t)r * INW + C_U2;
#pragma unroll
        for (int j = 0; j < 8; ++j) {
            const int cc = 4 * lane + 256 * j;
            const f32x4 gg = *(const f32x4*)(c.g_pre2 + cc), sc = *(const f32x4*)(md + MOD_SC2 + cc), sh = *(const f32x4*)(md + MOD_SH2 + cc);
            const f32x4 o = (v[j] * rstd2) * gg * (sc + 1.f) + sh;
            u32x2 w; w.x = pk2(o.x, o.y); w.y = pk2(o.z, o.w); *(u32x2*)(orow + cc) = w;
        }
    } }
    PM_SYNC();
    const int nparts = ntile >= 2 ? 2 : 1, ptiles = ntile / nparts;
    for (int hfi = 0; hfi < nparts * REP_FFN; ++hfi) {
        const int hf = hfi % nparts;
        const int pm0 = tile_lo + hf * ptiles, nM = ptiles, prow_lo = pm0 * 256;
        {
            pg8::Gemm g{P + (size_t)prow_lo * INW + C_U2, INW, c.WUP, DM, -1, nullptr}; pg8::StaticOrder S; S.init(nM, UPW / 256, G, cb);
            EpiUp E{P, c.out, pm0};
            pg8::gemm_phase<EpiUp, pg8::StaticOrder, true, true>(lds, g, S, E);
        }
        PM_SYNC();
        {   PM_TID();
            const int nitems = (nM * 16) * 11;
            for (int it = gw; it < nitems; it += NGW) {
                const int rg = it / 11, ch = it % 11, r0 = prow_lo + rg * 16, c0 = ch * 512 + lane * 8;
                float wv_[3][8], wg_[3][8], bv_[8], bg_[8];
#pragma unroll
                for (int t = 0; t < 3; ++t)
#pragma unroll
                    for (int e = 0; e < 8; ++e) { wv_[t][e] = c.conv_w[(size_t)t * UPW + c0 + e]; wg_[t][e] = c.conv_w[(size_t)t * UPW + DFF + c0 + e]; }
#pragma unroll
                for (int e = 0; e < 8; ++e) { bv_[e] = c.conv_b[c0 + e]; bg_[e] = c.conv_b[DFF + c0 + e]; }
                float pv[2][8], pg[2][8];
                const bool smp = r0 >= MP;
                const int tfirst = smp ? 0 : (r0 & 4095);
#pragma unroll
                for (int k = 0; k < 2; ++k) {
                    if (smp) { const float* sp = c.state_conv + ((size_t)((r0 - MP) >> 4) * 2 + k) * UPW + c0;
#pragma unroll
                        for (int e = 0; e < 8; ++e) { pv[k][e] = sp[e]; pg[k][e] = sp[DFF + e]; } }
                    else if (tfirst == 0) {
#pragma unroll
                        for (int e = 0; e < 8; ++e) { pv[k][e] = 0.f; pg[k][e] = 0.f; } }
                    else { const bf16_t* up = P + (size_t)(r0 - 2 + k) * INW + C_UP + c0; const u32x4 a4 = *(const u32x4*)up, b4 = *(const u32x4*)(up + DFF);
#pragma unroll
                        for (int q = 0; q < 4; ++q) { pv[k][2 * q] = __uint_as_float(a4[q] << 16); pv[k][2 * q + 1] = __uint_as_float(a4[q] & 0xffff0000u); pg[k][2 * q] = __uint_as_float(b4[q] << 16); pg[k][2 * q + 1] = __uint_as_float(b4[q] & 0xffff0000u); } }
                }
                bf16_t* hp = h_row(c, r0) + c0;
                u32x4 na[4], nb[4];
#pragma unroll
                for (int q = 0; q < 4; ++q) { const bf16_t* up = P + (size_t)(r0 + q) * INW + C_UP + c0; na[q] = *(const u32x4*)up; nb[q] = *(const u32x4*)(up + DFF); }
#pragma unroll
                for (int tb = 0; tb < 4; ++tb) {
                    u32x4 ca[4], cbv[4];
#pragma unroll
                    for (int q = 0; q < 4; ++q) { ca[q] = na[q]; cbv[q] = nb[q]; }
                    if (tb < 3) {
#pragma unroll
                        for (int q = 0; q < 4; ++q) { const bf16_t* up = P + (size_t)(r0 + 4 * tb + 4 + q) * INW + C_UP + c0; na[q] = *(const u32x4*)up; nb[q] = *(const u32x4*)(up + DFF); }
                    }
#pragma unroll
                    for (int q = 0; q < 4; ++q) {
                        const u32x4 a4 = ca[q], b4 = cbv[q];
                        float cv_[8], cg_[8], hv[8];
#pragma unroll
                        for (int qq = 0; qq < 4; ++qq) { cv_[2 * qq] = __uint_as_float(a4[qq] << 16); cv_[2 * qq + 1] = __uint_as_float(a4[qq] & 0xffff0000u); cg_[2 * qq] = __uint_as_float(b4[qq] << 16); cg_[2 * qq + 1] = __uint_as_float(b4[qq] & 0xffff0000u); }
#pragma unroll
                        for (int e = 0; e < 8; ++e) {
                            const float val = bv_[e] + wv_[2][e] * cv_[e] + wv_[1][e] * pv[1][e] + wv_[0][e] * pv[0][e];
                            const float gt = bg_[e] + wg_[2][e] * cg_[e] + wg_[1][e] * pg[1][e] + wg_[0][e] * pg[0][e];
                            const float gl = gt * __builtin_amdgcn_rcpf(1.f + __expf(-1.5957691216057308f * (gt + 0.044715f * gt * gt * gt)));
                            hv[e] = gl * val;
                            pv[0][e] = pv[1][e]; pv[1][e] = cv_[e]; pg[0][e] = pg[1][e]; pg[1][e] = cg_[e];
                        }
                        u32x4 w; w.x = pk2(hv[0], hv[1]); w.y = pk2(hv[2], hv[3]); w.z = pk2(hv[4], hv[5]); w.w = pk2(hv[6], hv[7]);
                        *(u32x4*)(hp + (size_t)(4 * tb + q) * INW) = w;
                    }
                }
            }
        }
#ifndef CHAIN_DOWN
#define CHAIN_DOWN 1
#endif
        if (SUB && !CHAIN_DOWN) return;
        PM_SYNC();
        if constexpr (SUB) {
            constexpr int KS = 4, KSL = DFF / KS;
            pg8::Gemm g{c.HS, INW, c.WDN, KSL, -1, nullptr, DFF, (size_t)KSL * 2, (size_t)KSL * 2}; pg8::StaticOrder S; S.init(KS, 8, G, cb);
            EpiPart E{c.PART};
            pg8::gemm_phase<EpiPart, pg8::StaticOrder, true, true>(lds, g, S, E);
            PM_SYNC();
            { PM_TID(); for (int r = row_lo + gw; r < row_hi; r += NGW) {
                const float* md = c.MOD + (size_t)mod_row(r) * MODW;
                f32x4 f[8]; float s = 0.f;
#pragma unroll
                for (int j = 0; j < 8; ++j) {
                    const int cc = 4 * lane + 256 * j;
                    const float* pp = c.PART + (size_t)(r - row_lo) * DM + cc;
                    f[j] = (*(const f32x4*)pp + *(const f32x4*)(pp + (size_t)256 * DM)) + (*(const f32x4*)(pp + (size_t)512 * DM) + *(const f32x4*)(pp + (size_t)768 * DM));
                    s += (f[j].x * f[j].x + f[j].y * f[j].y) + (f[j].z * f[j].z + f[j].w * f[j].w);
                }
                const float rstd = rsqrtf(wave_sum(s) * (1.f / DM) + EPS);
#pragma unroll
                for (int j = 0; j < 8; ++j) {
                    const int cc = 4 * lane + 256 * j;
                    const f32x4 x1 = *(const f32x4*)(c.Y + (size_t)r * DM + cc), gp = *(const f32x4*)(c.g_post2 + cc), gt = *(const f32x4*)(md + MOD_GT2 + cc);
                    *(f32x4*)(c.Y + (size_t)r * DM + cc) = x1 + gt * (f[j] * rstd * gp);
                }
            } }
            return;
        }
        {
            const bool last = !CHAIN_DOWN && !SUB && hf == nparts - 1;
            pg8::Gemm g{h_row(c, prow_lo), INW, c.WDN, DFF, last ? nM : -1, c.HS}; pg8::StaticOrder S; S.init(last ? nM + 1 : nM, 8, G, cb);
            EpiSsq<false> E{P, C_F, c.SSQ, pm0};
            pg8::gemm_phase<EpiSsq<false>, pg8::StaticOrder, true, true>(lds, g, S, E);
        }
        PM_SYNC();
    }
    { PM_TID(); for (int r = row_lo + gw; r < (CHAIN_DOWN ? row_hi : MTOT); r += NGW) {
        const float* md = c.MOD + (size_t)mod_row(r) * MODW;
        const bf16_t* fr = P + (size_t)r * INW + C_F;
        const float q = lane < 32 ? c.SSQ[(size_t)r * 32 + lane] : 0.f;
        const float rstd = rsqrtf(wave_sum(q) * (1.f / DM) + EPS);
#pragma unroll
        for (int j = 0; j < 8; ++j) {
            const int cc = 4 * lane + 256 * j;
            const u32x2 fb = *(const u32x2*)(fr + cc);
            const f32x4 f = (f32x4){__uint_as_float(fb.x << 16), __uint_as_float(fb.x & 0xffff0000u), __uint_as_float(fb.y << 16), __uint_as_float(fb.y & 0xffff0000u)};
            const f32x4 x1 = *(const f32x4*)(c.Y + (size_t)r * DM + cc), gp = *(const f32x4*)(c.g_post2 + cc), gt = *(const f32x4*)(md + MOD_GT2 + cc);
            *(f32x4*)(c.Y + (size_t)r * DM + cc) = x1 + gt * (f * rstd * gp);
        }
    } }
#undef PM_SYNC
#undef PM_TID
}

__global__ void __launch_bounds__(512, 2) fwd_kernel(Args a) {
    extern __shared__ __attribute__((aligned(16))) unsigned char lds_raw[];
    LAS unsigned char* lds = (LAS unsigned char*)lds_raw;
    cg::grid_group grid = cg::this_grid();
    volatile LAS unsigned* bst = (volatile LAS unsigned*)(lds + LDS_BYTES - 64);
    if (threadIdx.x < 2) bst[threadIdx.x] = 0u;
    __syncthreads();
    const XcdBarrier xbar = xcd_barrier_post((unsigned*)(a.ws + WS_CTL) + 1024, bst);
    if (threadIdx.x == 0) bst[2] = atomicAdd((unsigned*)(a.ws + WS_CTL) + 256 + 16 * xbar.x, 1u);
#define GSYNC() xcd_barrier(xbar)
    const int G = gridDim.x, bid = blockIdx.x, NGW = G * 8;
#define PHASE_TID() int tid = threadIdx.x; asm volatile("" : "+v"(tid)); const int lane = tid & 63, wv = __builtin_amdgcn_readfirstlane(tid >> 6), gw = bid * 8 + wv; (void)lane; (void)gw
    const float *x_p = a.in[0], *x_s = a.in[1], *cache_k = a.in[2], *cache_v = a.in[3], *state_ret = a.in[4], *state_conv = a.in[5], *c_p = a.in[6], *c_s = a.in[7],
                *w_ada = a.in[8], *b_ada = a.in[9], *g_pre1 = a.in[10], *w_in = a.in[11], *rel_bias = a.in[12], *w_br_ret = a.in[13], *w_br_att = a.in[14], *w_out = a.in[15],
                *g_post1 = a.in[16], *g_pre2 = a.in[17], *w_up = a.in[18], *conv_w = a.in[19], *conv_b = a.in[20], *w_down = a.in[21], *g_post2 = a.in[22];
    float* out = a.out; unsigned char* ws = a.ws;
    unsigned* ctl = (unsigned*)(ws + WS_CTL);
    bf16_t *WIN = (bf16_t*)(ws + WS_WIN), *WUP = (bf16_t*)(ws + WS_WUP), *WDN = (bf16_t*)(ws + WS_WDN), *WBR = (bf16_t*)(ws + WS_WBR), *WBA = (bf16_t*)(ws + WS_WBA), *WOUT = (bf16_t*)(ws + WS_WOUT);
    float *MODP = (float*)(ws + WS_MODP), *MOD = (float*)(ws + WS_MOD), *SSQ = (float*)(ws + WS_SSQ);
    bf16_t *HS = (bf16_t*)(ws + WS_HS), *P = (bf16_t*)(ws + WS_PROJ);
    bf16_t* U = (bf16_t*)out;
    float* Y = out + OFF_Y;
    Ctx cx; cx.P = P; cx.HS = HS; cx.WBR = WBR; cx.WBA = WBA; cx.WOUT = WOUT; cx.WUP = WUP; cx.WDN = WDN; cx.out = out; cx.Y = Y; cx.SSQ = SSQ; cx.MOD = MOD;
    cx.x_p = x_p; cx.x_s = x_s; cx.g_post1 = g_post1; cx.g_pre2 = g_pre2; cx.g_post2 = g_post2; cx.conv_w = conv_w; cx.conv_b = conv_b; cx.state_conv = state_conv;
    cx.subbar = ctl + 64; cx.lds = lds; cx.xbar = xbar; cx.PART = MODP;

    if (PH(0)) {
        PHASE_TID();
        LAS float* scr = (LAS float*)(lds + wv * TR_BYTES);
        constexpr int I_IN = 64 * (INW / 128), I_UP = 64 * (UPW / 128), I_DN = (DFF / 32) * 16, I_BR = 64 * 16, I_BA = 32 * 16, I_OUT = 64 * 16, I_MOD = 16 * 48;
        constexpr int NIT = I_IN + I_UP + I_DN + I_BR + I_BA + I_OUT + I_MOD;
        for (int it = gw; it < NIT; it += NGW) {
            int r = it;
            if (r < I_MOD) { mod_item(c_p, c_s, w_ada, MODP, scr, r, lane); continue; } r -= I_MOD;
            if (r < I_IN) { transpose_item(w_in, DM, INW, WIN, scr, r, lane, true); continue; } r -= I_IN;
            if (r < I_UP) { transpose_item(w_up, DM, UPW, WUP, scr, r, lane, false); continue; } r -= I_UP;
            if (r < I_DN) { transpose_item(w_down, DFF, DM, WDN, scr, r, lane, false); continue; } r -= I_DN;
            if (r < I_BR) { transpose_item(w_br_ret, DM, DM, WBR, scr, r, lane, false); continue; } r -= I_BR;
            if (r < I_BA) { transpose_item(w_br_att, 1024, DM, WBA, scr, r, lane, false); continue; } r -= I_BA;
            transpose_item(w_out, DM, DM, WOUT, scr, r, lane, false);
        }
    }
    grid.sync();
    {
        if (threadIdx.x == 0) {
            const unsigned* xc = (const unsigned*)(a.ws + WS_CTL) + 256; const unsigned rk = bst[2]; unsigned v = 0;
            for (unsigned j = 0; j < 16; ++j) { const unsigned n = __hip_atomic_load(xc + 16 * j, __ATOMIC_RELAXED, __HIP_MEMORY_SCOPE_AGENT); v += n < rk ? n : rk; if (j < xbar.x && n > rk) ++v; }
            bst[3] = v;
        }
        __syncthreads();
    }
    const int vbid = (int)bst[3];
    if (PH(1)) { PHASE_TID(); for (int i = bid * 512 + tid; i < 24 * MODW / 4; i += G * 512) {
        const int r = i / (MODW / 4), c4 = (i % (MODW / 4)) * 4;
        f32x4 s = *(const f32x4*)(b_ada + c4);
#pragma unroll
        for (int sl = 0; sl < 16; ++sl) s += *(const f32x4*)(MODP + ((size_t)sl * 24 + r) * MODW + c4);
        *(f32x4*)(MOD + (size_t)r * MODW + c4) = s;
    } }
    GSYNC();
    if (PH(2)) { PHASE_TID(); for (int r = gw; r < MTOT; r += NGW) {
        const float* xr = r < MP ? x_p + (size_t)r * DM : x_s + (size_t)(r - MP) * DM;
        const float* md = MOD + (size_t)mod_row(r) * MODW;
        norm_mod_row(xr, g_pre1, md + MOD_SC1, md + MOD_SH1, U + (size_t)r * DM, lane);
    } }
    GSYNC();
    for (int rep1 = 0; rep1 < REP_P1; ++rep1) if (PH(3)) {
        pg8::Gemm g{U, DM, WIN, DM, -1, nullptr}; pg8::StaticOrder S; S.init(NTILE, INW / 256, G, vbid);
        EpiProj E{P, out};
        pg8::gemm_phase<EpiProj, pg8::StaticOrder, true, true>(lds, g, S, E);
    }
    GSYNC();
#ifdef DRY_P2
    {   PHASE_TID();
        LAS float* bl = (LAS float*)lds;
        for (int i = tid; i < 8 * 257; i += 512) bl[i] = rel_bias[i];
        __syncthreads();
        if (bid < 64) {
            ret_prompt_unit<true>(P, out, bid >> 3, bid & 7, lds, tid);
            __syncthreads();
            for (int i = tid; i < 8 * 257; i += 512) bl[i] = rel_bias[i];
            __syncthreads();
        }
        int tid_b = threadIdx.x; asm volatile("" : "+v"(tid_b)); const int lane_b = tid_b & 63;
        for (;;) {
            unsigned u = 0; if (lane_b == 0) u = atomicAdd(ctl + 1, 1u);
            u = (unsigned)__builtin_amdgcn_readfirstlane((int)u);
            if (u >= 8192u) break;
            att_unit<true>(P, (LAS float*)lds, (int)u, lane_b);
        }
    }
    GSYNC();
#endif
#ifdef DRY_ATT
    {   PHASE_TID();
        LAS float* bl = (LAS float*)lds;
        for (int i = tid; i < 8 * 257; i += 512) bl[i] = rel_bias[i];
        __syncthreads();
        for (;;) {
            unsigned u = 0; if (lane == 0) u = atomicAdd(ctl + 1, 1u);
            u = (unsigned)__builtin_amdgcn_readfirstlane((int)u);
            if (u >= 8192u) break;
            att_unit<true>(P, bl, (int)u, lane);
        }
    }
    GSYNC();
#endif
#ifdef DRY_RET
    {   PHASE_TID();
        if (bid < 64) ret_prompt_unit<true>(P, out, bid >> 3, bid & 7, lds, tid);
    }
    GSYNC();
#endif
    if (PH(4)) {
        PHASE_TID();
        LAS float* bl = (LAS float*)lds;
        for (int i = tid; i < 8 * 257; i += 512) bl[i] = rel_bias[i];
        __syncthreads();
        LAS unsigned char* scr = lds + 8448;
        constexpr int NSB = 44;
        {
            for (int u = bid; u < 256; u += G) {
                if (u < 128) { if (P2SUB & 2) ret_sample_unit(P, state_ret, out, u >> 3, u & 7, scr, tid); }
                else { if (P2SUB & 4) att_sample_unit(P, cache_k, cache_v, rel_bias, (u - 128) >> 3, (u - 128) & 7, scr, tid); }
            }
            asm volatile("s_waitcnt vmcnt(0)" ::: "memory");
            __syncthreads();
            if (tid == 0) { __builtin_amdgcn_fence(__ATOMIC_RELEASE, "agent"); asm volatile("s_waitcnt vmcnt(0)" ::: "memory"); (void)__hip_atomic_fetch_add(ctl + 128, 1u, __ATOMIC_RELAXED, __HIP_MEMORY_SCOPE_AGENT); }
        }
        if (bid < 64) { if (P2SUB & 1) ret_prompt_unit<false>(P, out, bid >> 3, bid & 7, lds, tid); }
        else {
            if (bid < 64 + NSB) {
                if (tid == 0) { unsigned sp = 0; while (__hip_atomic_load(ctl + 128, __ATOMIC_RELAXED, __HIP_MEMORY_SCOPE_AGENT) < (unsigned)G) { __builtin_amdgcn_s_sleep(2); if (++sp > (1u << 22)) break; }
                    __builtin_amdgcn_fence(__ATOMIC_ACQUIRE, "agent"); asm volatile("s_waitcnt vmcnt(0)" ::: "memory"); }
                __syncthreads();
                unsigned sg = 0;
                post_mixer<true>(cx, 128, 1, NSB, bid - 64, sg);
                __syncthreads();
                for (int i = tid; i < 8 * 257; i += 512) bl[i] = rel_bias[i];
                __syncthreads();
            }
        }
        int tid_b = threadIdx.x; asm volatile("" : "+v"(tid_b)); const int lane_b = tid_b & 63;
        for (unsigned kq = 0; kq < 8; ++kq) {
            const unsigned q = (xbar.x + kq) & 7u;
            for (;;) {
                unsigned u = 0; if (lane_b == 0) u = atomicAdd(ctl + 512 + 16 * q, 1u);
                u = (unsigned)__builtin_amdgcn_readfirstlane((int)u);
                if (u >= 1024u) break;
                if (P2SUB & 8) att_unit<false>(P, (LAS float*)lds, (int)(q * 1024u + u), lane_b);
            }
        }
    }
    GSYNC();
    {
        unsigned sg = 0;
        post_mixer<false>(cx, 0, 128, G, vbid, sg);
    }
}

extern "C" void kernel_launch(void* const* d_in, const int* in_sizes, int n_in, void* d_out, int out_size, void* d_ws, size_t ws_size, hipStream_t stream) {
    static int grid = 0;
    if (grid == 0) {
        if (n_in != 23 || ws_size < WS_END) { fprintf(stderr, "kernel_launch: unexpected inputs (n_in %d, ws %zu, need %zu)\n", n_in, ws_size, (size_t)WS_END); grid = -1; return; }
        int dev = 0, cus = 0, per_cu = 0;
        (void)hipGetDevice(&dev); (void)hipDeviceGetAttribute(&cus, hipDeviceAttributeMultiprocessorCount, dev);
        if (hipFuncSetAttribute((const void*)fwd_kernel, hipFuncAttributeMaxDynamicSharedMemorySize, LDS_BYTES) != hipSuccess) { fprintf(stderr, "kernel_launch: hipFuncSetAttribute failed\n"); grid = -1; return; }
        if (hipOccupancyMaxActiveBlocksPerMultiprocessor(&per_cu, (const void*)fwd_kernel, 512, LDS_BYTES) != hipSuccess || per_cu < 1) per_cu = 1;
        (void)hipGetLastError();
        grid = cus * 1;
        if (grid <= 0) grid = 256;
    }
    if (grid < 0) return;
    (void)hipMemsetAsync((char*)d_ws + WS_CTL, 0, 65536, stream);
    Args a{};
    for (int i = 0; i < 23; ++i) a.in[i] = (const float*)d_in[i];
    a.out = (float*)d_out; a.ws = (unsigned char*)d_ws;
    void* args[] = {&a};
    hipError_t e = hipLaunchCooperativeKernel((const void*)fwd_kernel, dim3(grid), dim3(512), args, LDS_BYTES, stream);
    if (e != hipSuccess) fprintf(stderr, "kernel_launch: cooperative launch failed: %s (grid %d)\n", hipGetErrorString(e), grid);
}
```
